# Optimizing an MI355X kernel written in HIP

```python
import functools
import jax
import jax.numpy as jnp
from jax import lax
import numpy as np

D_MODEL = 1024
BATCH = 2
SEQ = 8192
DEPTH = 2
DEC_BATCH = 4
DEC_SEQ = 4096
PAST_LEN = 128

ATT_HD = 64
ATT_W = 3 * D_MODEL // 8
ATT_HEADS = ATT_W // ATT_HD
WINDOWS = (128, 512, 2048)
DILATIONS = (1, 4, 16)
CONV_W = D_MODEL // 4
CONV_K = 3
RW_HD = 64
RW = 3 * D_MODEL // 8
RW_HEADS = RW // RW_HD
DECAY_RANK = 64
A_RANK = 64
G_RANK = 128
RWKV_COLS = 3 * RW + 2 * DECAY_RANK + 2 * A_RANK + G_RANK
D_MIX = ATT_W + CONV_W + RW
D_IN_TOTAL = 3 * ATT_W + 3 * CONV_W + RWKV_COLS
D_FF = 2816
N_BUCKETS = 32
REL_MAX_DIST = 1024
ALPHA = (2 * DEPTH) ** 0.25
BETA = (8 * DEPTH) ** -0.25
LN_EPS = 1e-5
GN_EPS = 64e-5
NEG_INF = -1e9
F32 = jnp.float32

kernel_name = 'hymba_style_dilated_conv_rwkv7_encoder'


def _layer_norm(x, g, b, eps=LN_EPS):
    xf = x.astype(F32)
    mu = jnp.mean(xf, -1, keepdims=True)
    var = jnp.mean(jnp.square(xf - mu), -1, keepdims=True)
    return (xf - mu) * lax.rsqrt(var + eps) * g + b


def _modulate(x, mod, i):
    return x * (1 + mod[:, i, 1, None]) + mod[:, i, 0, None]


def _post_norm(x, delta, mod, i, g, b):
    return _layer_norm(ALPHA * x + (1 + mod[:, i, 2, None]) * delta, g, b).astype(x.dtype)


def _swiglu(h, w_in, w_out):
    gate, up = jnp.split(h @ w_in, 2, axis=-1)
    return (jax.nn.silu(gate) * up) @ w_out


def _t5_bucket(rel):
    half = N_BUCKETS // 2
    exact = half // 2
    n = np.abs(rel)
    large = exact + (np.log(np.maximum(n, exact) / exact) / np.log(REL_MAX_DIST / exact) * (half - exact)).astype(np.int64)
    large = np.minimum(large, half - 1)
    return (np.where(rel > 0, half, 0) + np.where(n < exact, n, large)).astype(np.int32)


def _dilated_branch(q, k, v, rel_bias, window, dilation):
    bt, s, h, dh = q.shape
    n_half = window // (2 * dilation)
    blk = n_half
    L = s // dilation
    nb = -(-L // blk)
    lp = nb * blk

    def to_sub(t):
        return t.reshape(bt, L, dilation, h, dh).transpose(0, 2, 1, 3, 4).reshape(bt * dilation, L, h, dh)

    qs, ks, vs = to_sub(q), to_sub(k), to_sub(v)
    qb = jnp.pad(qs, ((0, 0), (0, lp - L), (0, 0), (0, 0))).reshape(-1, nb, blk, h, dh)

    def neighbours(t):
        tp = jnp.pad(t, ((0, 0), (blk, lp - L + blk), (0, 0), (0, 0))).reshape(-1, nb + 2, blk, h, dh)
        return jnp.concatenate([tp[:, :-2], tp[:, 1:-1], tp[:, 2:]], axis=2)

    kb, vb = neighbours(ks), neighbours(vs)
    logits = jnp.einsum('nbqhd,nbkhd->nbhqk', qb, kb).astype(F32) * (dh ** -0.5)
    rel = np.arange(3 * blk)[None, :] - blk - np.arange(blk)[:, None]
    bias = jnp.take(rel_bias, jnp.asarray(_t5_bucket(rel * dilation)), axis=0)
    bias = jnp.transpose(bias, (2, 0, 1)).astype(F32)
    keypos = np.arange(nb)[:, None] * blk - blk + np.arange(3 * blk)[None, :]
    valid = (np.abs(rel) <= n_half)[None] & ((keypos >= 0) & (keypos < L))[:, None, :]
    logits = jnp.where(jnp.asarray(valid)[None, :, None], logits + bias, NEG_INF)
    m = jnp.max(logits, -1)
    p = jnp.exp(logits - m[..., None])
    l = jnp.sum(p, -1)
    o = jnp.einsum('nbhqk,nbkhd->nbqhd', p, vb.astype(F32)) / jnp.swapaxes(l, 2, 3)[..., None]

    def from_sub(t):
        t = t.reshape(bt, dilation, lp, *t.shape[3:])[:, :, :L]
        return jnp.swapaxes(t, 1, 2).reshape(bt, s, *t.shape[3:])

    return from_sub(jnp.swapaxes(m, 2, 3)), from_sub(jnp.swapaxes(l, 2, 3)), from_sub(o)


def _dilated_attention(q, k, v, rel_bias):
    bt, s = q.shape[:2]
    parts = [_dilated_branch(q, k, v, rel_bias, w, d) for w, d in zip(WINDOWS, DILATIONS)]
    m_max = functools.reduce(jnp.maximum, [m for m, _, _ in parts])
    wts = [l * jnp.exp(m - m_max) for m, l, _ in parts]
    num = sum(w[..., None] * o for w, (_, _, o) in zip(wts, parts))
    den = sum(wts)
    return (num / den[..., None]).reshape(bt, s, ATT_W)


def _short_conv(gb, gc, hin, conv_w):
    u = gc * hin
    up = jnp.pad(u, ((0, 0), (1, 1), (0, 0)))
    y = conv_w[0] * up[:, :-2] + conv_w[1] * up[:, 1:-1] + conv_w[2] * up[:, 2:]
    return gb * y


def _heads(t):
    return t.reshape(*t.shape[:-1], RW_HEADS, RW_HD)


def _rwkv7_bidir(z, mu, w0, w_up, a0, a_up, g_up, k_k, k_a, r_k, gn_g, gn_b):
    bt, s, _ = z.shape
    z = z.astype(F32)
    zp = jnp.pad(z, ((0, 0), (1, 1), (0, 0)))
    z = z + mu * (0.5 * (zp[:, :-2] + zp[:, 2:]) - z)
    r, k, v = z[..., :RW], z[..., RW:2 * RW], z[..., 2 * RW:3 * RW]
    o = 3 * RW
    wd = z[..., o:o + 2 * DECAY_RANK].reshape(bt, s, 2, DECAY_RANK)
    o += 2 * DECAY_RANK
    ad = z[..., o:o + 2 * A_RANK].reshape(bt, s, 2, A_RANK)
    o += 2 * A_RANK
    gd = z[..., o:o + G_RANK]
    w = w0 + jnp.einsum('bsjr,jrc->bsjc', jnp.tanh(wd), w_up)
    decay = jnp.exp(-jnp.exp(-jax.nn.softplus(-w) - 0.5))
    a = jax.nn.sigmoid(a0 + jnp.einsum('bsjr,jrc->bsjc', ad, a_up))
    g = jax.nn.sigmoid(gd) @ g_up
    kk = _heads(k * k_k)
    kk = kk / jnp.maximum(jnp.sqrt(jnp.sum(jnp.square(kk), -1, keepdims=True)), 1e-12)
    k_dir = _heads(k[:, :, None] * (1 + (a - 1) * k_a))
    a_h, decay_h = _heads(a), _heads(decay)
    r_h, k_h, v_h = _heads(r), _heads(k), _heads(v)

    def seq_major(t_f, t_b):
        return jnp.stack([t_f, t_b[:, ::-1]], axis=0).transpose(2, 0, 1, 3, 4)

    xs = (seq_major(r_h, r_h), seq_major(decay_h[:, :, 0], decay_h[:, :, 1]),
          seq_major(k_dir[:, :, 0], k_dir[:, :, 1]), seq_major(v_h, v_h),
          seq_major(kk, kk), seq_major(a_h[:, :, 0], a_h[:, :, 1]))

    def step(state, inp):
        r_t, w_t, k_t, v_t, kk_t, a_t = inp
        sa = jnp.einsum('dbhvk,dbhk->dbhv', state, kk_t)
        state = (state * w_t[..., None, :] - sa[..., :, None] * (kk_t * a_t)[..., None, :]
                 + v_t[..., :, None] * k_t[..., None, :])
        return state, jnp.einsum('dbhvk,dbhk->dbhv', state, r_t)

    state0 = jnp.zeros((2, bt, RW_HEADS, RW_HD, RW_HD), F32)
    _, ys = lax.scan(step, state0, xs)
    y = jnp.swapaxes(ys[:, 0] + ys[::-1, 1], 0, 1)
    ym = jnp.mean(y, -1, keepdims=True)
    yv = jnp.mean(jnp.square(y - ym), -1, keepdims=True)
    y = ((y - ym) * lax.rsqrt(yv + GN_EPS)).reshape(bt, s, RW) * gn_g + gn_b
    bonus = jnp.sum(r_h * k_h * r_k, -1, keepdims=True) * v_h
    return (y + bonus.reshape(bt, s, RW)) * g


def _mixer(h, w_in, w_out, rel_bias, conv_w, rw):
    bt, s, _ = h.shape
    u = h @ w_in
    q, k, v = [u[..., i * ATT_W:(i + 1) * ATT_W].reshape(bt, s, ATT_HEADS, ATT_HD) for i in range(3)]
    c0 = 3 * ATT_W
    gb, gc, hin = [u[..., c0 + i * CONV_W:c0 + (i + 1) * CONV_W] for i in range(3)]
    z = u[..., c0 + 3 * CONV_W:]
    att = _dilated_attention(q, k, v, rel_bias)
    conv = _short_conv(gb, gc, hin, conv_w).astype(F32)
    rwk = _rwkv7_bidir(z, *rw)
    return jnp.concatenate([att, conv, rwk], axis=-1) @ w_out


def _trunk(x, c, params):
    (w_ada, b_ada, ln_g, ln_b, ffn_w_in, ffn_w_out, w_mix_in, w_mix_out, rel_bias, conv_w,
     rwkv_mu, rwkv_w0, rwkv_w_up, rwkv_a0, rwkv_a_up, rwkv_g_up, rwkv_k_k, rwkv_k_a, rwkv_r_k,
     rwkv_gn_g, rwkv_gn_b) = params
    for l in range(DEPTH):
        mod = (c @ w_ada[l] + b_ada[l]).reshape(c.shape[0], 3, 3, D_MODEL)
        delta = 0.5 * _swiglu(_modulate(x, mod, 0), ffn_w_in[l, 0], ffn_w_out[l, 0])
        x = _post_norm(x, delta, mod, 0, ln_g[l, 0], ln_b[l, 0])
        rw = (rwkv_mu[l], rwkv_w0[l], rwkv_w_up[l], rwkv_a0[l], rwkv_a_up[l], rwkv_g_up[l],
              rwkv_k_k[l], rwkv_k_a[l], rwkv_r_k[l], rwkv_gn_g[l], rwkv_gn_b[l])
        delta = _mixer(_modulate(x, mod, 1), w_mix_in[l], w_mix_out[l], rel_bias, conv_w[l], rw)
        x = _post_norm(x, delta, mod, 1, ln_g[l, 1], ln_b[l, 1])
        delta = 0.5 * _swiglu(_modulate(x, mod, 2), ffn_w_in[l, 1], ffn_w_out[l, 1])
        x = _post_norm(x, delta, mod, 2, ln_g[l, 2], ln_b[l, 2])
    return x


def setup_inputs(seed: int = 0) -> dict:
    key = jax.random.key(seed)
    ks = jax.random.split(key, 25)
    nrm = jax.random.normal
    return {
        'x_prompt': nrm(ks[0], (BATCH, SEQ, D_MODEL), F32),
        'x_sample': nrm(ks[1], (DEC_BATCH, DEC_SEQ, D_MODEL), F32),
        'c_prompt': nrm(ks[2], (BATCH, D_MODEL), F32),
        'c_sample': nrm(ks[3], (DEC_BATCH, D_MODEL), F32),
        'w_ada': nrm(ks[4], (DEPTH, D_MODEL, 9 * D_MODEL), F32) * (0.1 * D_MODEL ** -0.5),
        'b_ada': nrm(ks[5], (DEPTH, 9 * D_MODEL), F32) * 0.01,
        'ln_g': 1.0 + 0.05 * nrm(ks[6], (DEPTH, 3, D_MODEL), F32),
        'ln_b': 0.02 * nrm(ks[7], (DEPTH, 3, D_MODEL), F32),
        'ffn_w_in': nrm(ks[8], (DEPTH, 2, D_MODEL, 2 * D_FF), F32) * D_MODEL ** -0.5,
        'ffn_w_out': nrm(ks[9], (DEPTH, 2, D_FF, D_MODEL), F32) * (BETA * D_FF ** -0.5),
        'w_mix_in': nrm(ks[10], (DEPTH, D_MODEL, D_IN_TOTAL), F32) * D_MODEL ** -0.5,
        'w_mix_out': nrm(ks[11], (DEPTH, D_MIX, D_MODEL), F32) * (BETA * D_MIX ** -0.5),
        'rel_bias': 0.2 * nrm(ks[12], (N_BUCKETS, ATT_HEADS), F32),
        'conv_w': nrm(ks[13], (DEPTH, CONV_K, CONV_W), F32) * CONV_K ** -0.5,
        'rwkv_mu': jax.random.uniform(ks[14], (DEPTH, RWKV_COLS), F32),
        'rwkv_w0': jax.random.uniform(ks[15], (DEPTH, 2, RW), F32, minval=-6.0, maxval=0.0),
        'rwkv_w_up': nrm(ks[16], (DEPTH, 2, DECAY_RANK, RW), F32) * (0.1 * DECAY_RANK ** -0.5),
        'rwkv_a0': 0.3 * nrm(ks[17], (DEPTH, 2, RW), F32),
        'rwkv_a_up': nrm(ks[18], (DEPTH, 2, A_RANK, RW), F32) * (0.1 * A_RANK ** -0.5),
        'rwkv_g_up': nrm(ks[19], (DEPTH, G_RANK, RW), F32) * G_RANK ** -0.5,
        'rwkv_k_k': 0.85 + 0.05 * nrm(ks[20], (DEPTH, RW), F32),
        'rwkv_k_a': 1.0 + 0.05 * nrm(ks[21], (DEPTH, RW), F32),
        'rwkv_r_k': 0.1 * nrm(ks[22], (DEPTH, RW_HEADS, RW_HD), F32),
        'rwkv_gn_g': 1.0 + 0.05 * nrm(ks[23], (DEPTH, RW), F32),
        'rwkv_gn_b': 0.02 * nrm(ks[24], (DEPTH, RW), F32),
    }


def reference(x_prompt, x_sample, c_prompt, c_sample, w_ada, b_ada, ln_g, ln_b, ffn_w_in, ffn_w_out,
              w_mix_in, w_mix_out, rel_bias, conv_w, rwkv_mu, rwkv_w0, rwkv_w_up, rwkv_a0, rwkv_a_up,
              rwkv_g_up, rwkv_k_k, rwkv_k_a, rwkv_r_k, rwkv_gn_g, rwkv_gn_b):
    params = (w_ada, b_ada, ln_g, ln_b, ffn_w_in, ffn_w_out, w_mix_in, w_mix_out, rel_bias, conv_w,
              rwkv_mu, rwkv_w0, rwkv_w_up, rwkv_a0, rwkv_a_up, rwkv_g_up, rwkv_k_k, rwkv_k_a, rwkv_r_k,
              rwkv_gn_g, rwkv_gn_b)
    y_prompt = _trunk(x_prompt, c_prompt, params)
    y_sample = _trunk(x_sample, c_sample, params)
    return (y_prompt, y_sample)
```

```cpp
#include <hip/hip_runtime.h>
#include <hip/hip_cooperative_groups.h>
#include <cstdio>
namespace cg = cooperative_groups;

#define LAS __attribute__((address_space(3)))
typedef unsigned short u16;
typedef short bf16x8 __attribute__((ext_vector_type(8)));
typedef short s16x4 __attribute__((ext_vector_type(4)));
typedef float f32x4 __attribute__((ext_vector_type(4)));
typedef float f32x2 __attribute__((ext_vector_type(2)));
typedef unsigned u32x4 __attribute__((ext_vector_type(4)));
typedef unsigned u32x2 __attribute__((ext_vector_type(2)));

constexpr int D = 1024, M = 32768, FF = 2816, NIN = 5632, NMIXP = 3584, N2 = 2048, K2 = 384;
constexpr int MPROMPT = 16384;
constexpr float ALPHA = 1.4142135623730951f;
constexpr float LN_EPS = 1e-5f, GN_EPS = 64e-5f;

constexpr size_t WS_MOD = 0;
constexpr size_t WS_W = 524288;
constexpr size_t W_FIN = 0, W_FOUT = W_FIN + 23068672, W_MIN = W_FOUT + 11534336, W_MOUT = W_MIN + 7340032, W_B2 = W_MOUT + 2097152, W_TOTAL = W_B2 + 1572864;
constexpr size_t WS_H = WS_W + W_TOTAL;
constexpr size_t WS_A2 = WS_H + (size_t)M * 1024 * 2;
constexpr size_t WS_R = WS_A2 + (size_t)M * 384 * 2;
constexpr size_t R_HID = 0;
constexpr size_t R_QKV = 0;
constexpr size_t R_CONV = R_QKV + (size_t)M * 1152 * 2;
constexpr size_t R_ZLAT = R_CONV + (size_t)M * 768 * 2;
constexpr size_t R_ZRKV = R_ZLAT + (size_t)M * 384 * 2;
constexpr size_t R_LD = 0;
constexpr size_t R_AA = R_LD + (size_t)2 * M * 384 * 2;
constexpr size_t R_YS = R_AA + (size_t)2 * M * 384 * 2;
constexpr size_t WS_STATS = WS_R + R_ZRKV + (size_t)M * 1152 * 2;
constexpr size_t WS_INV = WS_STATS + (size_t)M * 2 * 4;
constexpr size_t WS_END = WS_INV + (size_t)M * 6 * 4;
static_assert(R_YS + (size_t)2 * M * 384 * 2 <= R_ZRKV, "alias map");
constexpr int LDS_BYTES = 131072 + 16;
constexpr size_t WS_BAR = 458752;
#ifndef DUPK
#define DUPK 0
#endif
#define REPS(k) _Pragma("unroll 1") for (int rep_ = 0; rep_ < (DUPK == (k) ? 2 : 1); ++rep_)

__device__ __forceinline__ unsigned cvt_pk_bf16(float lo, float hi) { unsigned r; asm volatile("v_cvt_pk_bf16_f32 %0, %1, %2" : "=v"(r) : "v"(lo), "v"(hi)); return r; }
__device__ __forceinline__ float bf2f(u16 b) { return __uint_as_float(((unsigned)b) << 16); }
__device__ __forceinline__ unsigned pk_f16(float lo, float hi) { _Float16 a = (_Float16)lo, b = (_Float16)hi; return (unsigned)__builtin_bit_cast(u16, a) | ((unsigned)__builtin_bit_cast(u16, b) << 16); }
__device__ __forceinline__ float h2f(u16 h) { return (float)__builtin_bit_cast(_Float16, h); }
__device__ __forceinline__ float hlo(unsigned u) { return h2f((u16)(u & 0xffffu)); }
__device__ __forceinline__ float hhi(unsigned u) { return h2f((u16)(u >> 16)); }
__device__ __forceinline__ int row_batch(int m) { return m < MPROMPT ? (m >> 13) : 2 + ((m - MPROMPT) >> 12); }
__device__ __forceinline__ void row_info(int m, int& S, int& t) { if (m < MPROMPT) { S = 8192; t = m & 8191; } else { S = 4096; t = m & 4095; } }
__device__ __forceinline__ float sigmoidf_(float x) { return __builtin_amdgcn_rcpf(1.f + __expf(-x)); }
template <int CTRL> __device__ __forceinline__ float dpp_add(float x) {
    return x + __builtin_bit_cast(float, __builtin_amdgcn_update_dpp(0, __builtin_bit_cast(int, x), CTRL, 0xF, 0xF, true));
}
template <int CTRL, int BANK> __device__ __forceinline__ float dpp_mov(float oldv, float x) {
    return __builtin_bit_cast(float, __builtin_amdgcn_update_dpp(__builtin_bit_cast(int, oldv), __builtin_bit_cast(int, x), CTRL, 0xF, BANK, false));
}
__device__ __forceinline__ float allreduce8(float x) {
    x = dpp_add<0xB1>(x); x = dpp_add<0x4E>(x); x = dpp_add<0x141>(x); return x;
}
__device__ __forceinline__ float allreduce16(float x) {
    x = dpp_add<0xB1>(x);
    x = dpp_add<0x4E>(x);
    x = dpp_add<0x141>(x);
    x = dpp_add<0x140>(x);
    return x;
}

__device__ __forceinline__ int launder_v(int x) { asm volatile("" : "+v"(x)); return x; }
__device__ __forceinline__ int launder_s(int x) { asm volatile("" : "+s"(x)); return x; }
__device__ __forceinline__ int lane_id_asm() { int r; asm volatile("v_mbcnt_lo_u32_b32 %0, -1, 0\n\tv_mbcnt_hi_u32_b32 %0, -1, %0" : "=v"(r)); return r; }
__device__ __forceinline__ float wave_sum(float v) {
    v = allreduce16(v);
    const float r0 = __builtin_bit_cast(float, __builtin_amdgcn_readlane(__builtin_bit_cast(int, v), 0)), r1 = __builtin_bit_cast(float, __builtin_amdgcn_readlane(__builtin_bit_cast(int, v), 16));
    const float r2 = __builtin_bit_cast(float, __builtin_amdgcn_readlane(__builtin_bit_cast(int, v), 32)), r3 = __builtin_bit_cast(float, __builtin_amdgcn_readlane(__builtin_bit_cast(int, v), 48));
    return (r0 + r1) + (r2 + r3);
}
struct Args {
    const float* in[25];
    float* out;
    unsigned char* ws;
    int ph_lo, ph_hi;
};
struct Frame {
    const float* const* in;
    float* X;
    unsigned char* ws;
    LAS unsigned char* lds;
    int tid, lane, wave;
};
enum { I_XP = 0, I_XS, I_CP, I_CS, I_WADA, I_BADA, I_LNG, I_LNB, I_FWIN, I_FWOUT, I_WMIN, I_WMOUT, I_RELB, I_CONVW, I_MU, I_W0, I_WUP, I_A0, I_AUP, I_GUP, I_KK, I_KA, I_RK, I_GNG, I_GNB };

__device__ __forceinline__ const float* modp(const Frame& F, int l, int b, int i, int j) { return (const float*)(F.ws + WS_MOD) + ((size_t)((l * 6 + b) * 9 + i * 3 + j)) * 1024; }

namespace pg8 {
constexpr int BM = 256, BK = 64, HALF = 128, HTB = HALF * BK * 2, STAGE_BYTES = 8 * HTB, NXCD = 8, WGM = 8;
__device__ __forceinline__ int lds_byte(int r, int c) { const int st = (r >> 4) * 2 + (c >> 5), rr = r & 15, cc = c & 31, ob = rr * 64 + cc * 2; return st * 1024 + (ob ^ (((ob >> 9) & 1) << 5)); }
__device__ __forceinline__ void stage_rc(int b, int& R, int& C) { const int st = b / 1024, sb = b % 1024, swz = sb ^ (((sb >> 9) & 1) << 5); R = (st >> 1) * 16 + swz / 64; C = (st & 1) * 32 + (swz % 64) / 2; }
__device__ __forceinline__ int perm32(int rho) { const int n = rho >> 4, i = rho & 15; return 8 * (i >> 2) + 4 * n + (i & 3); }
struct Unit { int pm, pn; };
struct Gemm { const u16* A; const u16* Bt; int M, N, K; };
struct StaticOrder {
    int nM, nN, nwg, G, c;
    __device__ void init(int M_, int N_, int G_, int c_) { nM = M_ / BM; nN = N_ / BM; nwg = nM * nN; G = G_; c = c_; }
    __device__ bool next(int i, Unit& u) const {
        const long L = (long)i * G + c; if (L >= nwg) return false;
        int wgid = (int)L; { const int q = nwg / NXCD, r = nwg % NXCD, xcd = wgid % NXCD, off = wgid / NXCD; wgid = (xcd < r ? xcd * (q + 1) : r * (q + 1) + (xcd - r) * q) + off; }
        const int nig = WGM * nN, gid = wgid / nig, fm = gid * WGM, gsz = (nM - fm) < WGM ? (nM - fm) : WGM;
        u.pm = fm + ((wgid % nig) % gsz); u.pn = (wgid % nig) / gsz; return true;
    }
};
template <class Epi>
__device__ __forceinline__ void gemm_phase(LAS unsigned char* lds, const Gemm g, const StaticOrder& S, const Epi& E, int tid) {
    const int wid = __builtin_amdgcn_readfirstlane(tid >> 6), lane = tid & 63, wr = wid >> 2, wc = wid & 3, fr = lane & 15, fq = lane >> 4;
    const int K = g.K, nt = K / BK;
    unsigned voffA[2], voffB[2];
#pragma unroll
    for (int i = 0; i < 2; ++i) { int R, C; stage_rc(tid * 16 + i * 8192, R, C); const int Rb = Epi::PERM ? ((R & ~31) + perm32(R & 31)) : R;
        voffA[i] = (unsigned)(R * K + C) * 2u; voffB[i] = (unsigned)(Rb * K + C) * 2u; }
    const size_t kstep = (size_t)(BK * 2);
    const size_t hstep = (size_t)HALF * K * 2;
    const size_t tstep = 2 * hstep;
    const unsigned ldsw = (unsigned)wid * 1024u;
    const int aoff = lds_byte(wr * 64 + fr, fq * 8), boff = lds_byte(wc * 32 + fr, fq * 8);
#define PG8_SA(b, h) (((b) * 2 + (h)) * HTB)
#define PG8_SB(b, h) ((4 + (b) * 2 + (h)) * HTB)
#define PG8_STAGE(bufoff, gbase, voff) do { _Pragma("unroll") for (int _i = 0; _i < 2; ++_i) \
        __builtin_amdgcn_global_load_lds((const unsigned*)((const char*)(gbase) + (voff)[_i]), (LAS unsigned*)(lds + (bufoff) + ldsw + _i * 8192), 16, 0, 0); } while (0)
#define PG8_LDA(dst, b, h) do { _Pragma("unroll") for (int m = 0; m < 4; ++m) _Pragma("unroll") for (int k = 0; k < 2; ++k) dst[m][k] = *(const LAS bf16x8*)(lds + PG8_SA(b, h) + aoff + m * 2048 + k * 1024); } while (0)
#define PG8_LDB(dst, b, h) do { _Pragma("unroll") for (int n = 0; n < 2; ++n) _Pragma("unroll") for (int k = 0; k < 2; ++k) dst[n][k] = *(const LAS bf16x8*)(lds + PG8_SB(b, h) + boff + n * 2048 + k * 1024); } while (0)
#define PG8_MMA(ai, bj, At, Bt) do { __builtin_amdgcn_s_setprio(1); _Pragma("unroll") for (int m = 0; m < 4; ++m) _Pragma("unroll") for (int n = 0; n < 2; ++n) _Pragma("unroll") for (int k = 0; k < 2; ++k) \
        acc[ai][bj][m][n] = __builtin_amdgcn_mfma_f32_16x16x32_bf16(Bt[n][k], At[m][k], acc[ai][bj][m][n], 0, 0, 0); __builtin_amdgcn_s_setprio(0); } while (0)
#define PG8_WAIT_V(n) asm volatile("s_waitcnt vmcnt(" #n ")" ::: "memory")
#define PG8_WAIT_L(n) asm volatile("s_waitcnt lgkmcnt(" #n ")" ::: "memory")
#define PG8_BAR __builtin_amdgcn_s_barrier()
#define PG8_SCHED __builtin_amdgcn_sched_barrier(0)
    Unit cur, nxt; int ui = 0;
    if (!S.next(0, cur)) return;
    f32x4 acc[2][2][4][2];
#pragma unroll
    for (int a = 0; a < 2; ++a)
#pragma unroll
        for (int b = 0; b < 2; ++b)
#pragma unroll
            for (int m = 0; m < 4; ++m)
#pragma unroll
                for (int n = 0; n < 2; ++n) acc[a][b][m][n] = (f32x4){0.f, 0.f, 0.f, 0.f};
    bf16x8 At[4][2], B0[2][2], B1[2][2];
    const char* cA = (const char*)g.A + (size_t)cur.pm * tstep; const char* cB = (const char*)g.Bt + (size_t)cur.pn * tstep;
    PG8_STAGE(PG8_SB(0, 0), cB, voffB); PG8_STAGE(PG8_SB(0, 1), cB + hstep, voffB); PG8_STAGE(PG8_SA(0, 0), cA, voffA); PG8_STAGE(PG8_SA(0, 1), cA + hstep, voffA);
    if (wr == 1) PG8_BAR;
    PG8_WAIT_V(2); PG8_BAR;
    PG8_STAGE(PG8_SB(1, 0), cB + kstep, voffB); PG8_STAGE(PG8_SA(1, 0), cA + kstep, voffA); PG8_STAGE(PG8_SB(1, 1), cB + hstep + kstep, voffB);
    PG8_WAIT_V(6); PG8_BAR;
    for (;;) {
        const bool has_next = S.next(ui + 1, nxt);
        const char* nA = has_next ? (const char*)g.A + (size_t)nxt.pm * tstep : cA; const char* nB = has_next ? (const char*)g.Bt + (size_t)nxt.pn * tstep : cB;
#pragma unroll 1
        for (int t = 0; t < nt; t += 2) {
            const bool last = (t == nt - 2);
            const char* a1 = cA + (size_t)(t + 1) * kstep;
            const char* a2 = last ? nA : cA + (size_t)(t + 2) * kstep; const char* b2 = last ? nB : cB + (size_t)(t + 2) * kstep;
            const char* a3 = a2 + kstep; const char* b3 = b2 + kstep;
            PG8_LDB(B0, 0, 0); PG8_LDB(B1, 0, 1); PG8_SCHED; PG8_LDA(At, 0, 0); PG8_STAGE(PG8_SA(1, 1), a1 + hstep, voffA);
            PG8_WAIT_V(8); PG8_WAIT_L(0); PG8_BAR; PG8_MMA(0, 0, At, B0); PG8_MMA(0, 1, At, B1); PG8_BAR; PG8_SCHED;
            PG8_LDA(At, 0, 1); PG8_STAGE(PG8_SB(0, 0), b2, voffB); PG8_STAGE(PG8_SB(0, 1), b2 + hstep, voffB); PG8_STAGE(PG8_SA(0, 0), a2, voffA);
            PG8_WAIT_V(8); PG8_WAIT_L(0); PG8_BAR; PG8_MMA(1, 0, At, B0); PG8_MMA(1, 1, At, B1); PG8_BAR; PG8_SCHED;
            PG8_LDB(B0, 1, 0); PG8_LDB(B1, 1, 1); PG8_SCHED; PG8_LDA(At, 1, 0); PG8_STAGE(PG8_SA(0, 1), a2 + hstep, voffA);
            PG8_WAIT_V(8); PG8_WAIT_L(0); PG8_BAR; PG8_MMA(0, 0, At, B0); PG8_MMA(0, 1, At, B1); PG8_BAR; PG8_SCHED;
            PG8_LDA(At, 1, 1); PG8_STAGE(PG8_SB(1, 0), b3, voffB); PG8_STAGE(PG8_SB(1, 1), b3 + hstep, voffB); PG8_STAGE(PG8_SA(1, 0), a3, voffA);
            PG8_WAIT_V(8); PG8_WAIT_L(0); PG8_BAR; PG8_MMA(1, 0, At, B0); PG8_MMA(1, 1, At, B1); PG8_BAR; PG8_SCHED;
        }
        if (wr == 0) PG8_BAR;
        { const int l2 = lane_id_asm(); E(acc, cur, wr, wc, l2 & 15, l2 >> 4); }
        if (!has_next) break;
#pragma unroll
        for (int a = 0; a < 2; ++a)
#pragma unroll
            for (int b = 0; b < 2; ++b)
#pragma unroll
                for (int m = 0; m < 4; ++m)
#pragma unroll
                    for (int n = 0; n < 2; ++n) acc[a][b][m][n] = (f32x4){0.f, 0.f, 0.f, 0.f};
        cur = nxt; cA = nA; cB = nB; ++ui;
        if (wr == 1) PG8_BAR;
    }
    PG8_WAIT_V(0);
    PG8_BAR;
#undef PG8_SA
#undef PG8_SB
#undef PG8_STAGE
#undef PG8_LDA
#undef PG8_LDB
#undef PG8_MMA
#undef PG8_WAIT_V
#undef PG8_WAIT_L
#undef PG8_BAR
#undef PG8_SCHED
}
}

typedef const f32x4 (&AccRef)[2][2][4][2];

struct EpiSwiglu {
    static constexpr bool PERM = true;
    u16* H;
    __device__ __forceinline__ void operator()(AccRef acc, const pg8::Unit& u, int wr, int wc, int fr, int fq) const {
        const int row0 = u.pm * 256 + wr * 64 + fr, col0 = u.pn * 128 + wc * 32 + 8 * fq;
#pragma unroll
        for (int ai = 0; ai < 2; ++ai)
#pragma unroll
            for (int m = 0; m < 4; ++m) {
                float h[8];
#pragma unroll
                for (int n = 0; n < 2; ++n)
#pragma unroll
                    for (int e = 0; e < 4; ++e) { const float gt = acc[ai][0][m][n][e], up = acc[ai][1][m][n][e]; h[n * 4 + e] = gt * __builtin_amdgcn_rcpf(1.f + __expf(-gt)) * up; }
                u32x4 o = {cvt_pk_bf16(h[0], h[1]), cvt_pk_bf16(h[2], h[3]), cvt_pk_bf16(h[4], h[5]), cvt_pk_bf16(h[6], h[7])};
                __builtin_nontemporal_store(o, (u32x4*)(H + (size_t)(row0 + ai * 128 + m * 16) * FF + col0));
            }
    }
};
struct EpiResid {
    static constexpr bool PERM = false;
    float* X; const float* gate0; float scale;
    int pli; const float* lng; const float* lnb; const unsigned char* wsb;
    const float* xp; const float* xs;
    __device__ __forceinline__ void operator()(AccRef acc, const pg8::Unit& u, int wr, int wc, int fr, int fq) const {
        const int row0 = u.pm * 256 + wr * 64 + fr, col0 = u.pn * 256 + wc * 32 + 4 * fq;
        const int pl = launder_s(pli);
        const float* stats = pl >= 0 ? (const float*)(wsb + WS_STATS) : nullptr; const float* lg = lng + (size_t)(pl < 0 ? 0 : pl) * D; const float* lb = lnb + (size_t)(pl < 0 ? 0 : pl) * D;
        const float* gp = gate0 + (size_t)row_batch(u.pm * 256) * 9 * 1024;
        const float* src = pl >= 0 ? (const float*)X : (u.pm < MPROMPT / 256 ? xp : xs - (size_t)MPROMPT * D);
        float mu[8], rs[8];
#pragma unroll
        for (int i = 0; i < 8; ++i) { mu[i] = 0.f; rs[i] = ALPHA;
            if (stats) { const f32x2 sv = *(const f32x2*)(stats + (size_t)(row0 + (i >> 2) * 128 + (i & 3) * 16) * 2); mu[i] = sv[0]; rs[i] = sv[1]; } }
#pragma unroll
        for (int bj = 0; bj < 2; ++bj)
#pragma unroll
            for (int n = 0; n < 2; ++n) {
                const int cc = col0 + bj * 128 + n * 16;
                f32x4 gv = (*(const f32x4*)(gp + cc) + 1.f) * scale, G = (f32x4){1.f, 1.f, 1.f, 1.f}, Bc = (f32x4){0.f, 0.f, 0.f, 0.f};
                if (stats) { G = *(const f32x4*)(lg + cc) * ALPHA; Bc = *(const f32x4*)(lb + cc) * ALPHA; }
#pragma unroll
                for (int i = 0; i < 8; ++i) {
                    const size_t off = (size_t)(row0 + (i >> 2) * 128 + (i & 3) * 16) * D + cc;
                    float* p = X + off;
                    const f32x4 x = *(const f32x4*)(src + off);
                    *(f32x4*)p = ((x - mu[i]) * rs[i]) * G + Bc + gv * acc[i >> 2][bj][i & 3][n];
                }
            }
    }
};
struct EpiMixIn {
    static constexpr bool PERM = true;
    unsigned char* R;
    __device__ __forceinline__ void operator()(AccRef acc, const pg8::Unit& u, int wr, int wc, int fr, int fq) const {
        const int row0 = u.pm * 256 + wr * 64 + fr;
#pragma unroll
        for (int bj = 0; bj < 2; ++bj) {
            const int cb = u.pn * 256 + bj * 128;
            u16* base; int ld, cc; bool asbf = false;
            if (cb < 1152) { base = (u16*)(R + R_QKV); ld = 1152; cc = cb; asbf = true; }
            else if (cb < 1920) { base = (u16*)(R + R_CONV); ld = 768; cc = cb - 1152; }
            else if (cb < 3072) { base = (u16*)(R + R_ZRKV); ld = 1152; cc = cb - 1920; }
            else if (cb < 3456) { base = (u16*)(R + R_ZLAT); ld = 384; cc = cb - 3072; }
            else continue;
            cc += wc * 32 + 8 * fq;
#pragma unroll
            for (int ai = 0; ai < 2; ++ai)
#pragma unroll
                for (int m = 0; m < 4; ++m) {
                    const f32x4 a = acc[ai][bj][m][0], b = acc[ai][bj][m][1];
                    u32x4 o;
                    if (asbf) o = (u32x4){cvt_pk_bf16(a[0], a[1]), cvt_pk_bf16(a[2], a[3]), cvt_pk_bf16(b[0], b[1]), cvt_pk_bf16(b[2], b[3])};
                    else o = (u32x4){pk_f16(a[0], a[1]), pk_f16(a[2], a[3]), pk_f16(b[0], b[1]), pk_f16(b[2], b[3])};
                    __builtin_nontemporal_store(o, (u32x4*)(base + (size_t)(row0 + ai * 128 + m * 16) * ld + cc));
                }
        }
    }
};
struct EpiLowRank {
    static constexpr bool PERM = true;
    unsigned char* R; u16* MIX; const float* w0; const float* a0;
    __device__ __forceinline__ void operator()(AccRef acc, const pg8::Unit& u, int wr, int wc, int fr, int fq) const {
        const int row0 = u.pm * 256 + wr * 64 + fr;
#pragma unroll
        for (int bj = 0; bj < 2; ++bj) {
            const int cb = u.pn * 256 + bj * 128;
            if (cb >= 1920) continue;
            const int c8 = cb + wc * 32 + 8 * fq;
            const int kind = cb < 768 ? 0 : (cb < 1536 ? 1 : 2);
            float bias[8];
#pragma unroll
            for (int e = 0; e < 8; ++e) bias[e] = kind == 0 ? w0[c8 + e] : (kind == 1 ? a0[c8 - 768 + e] : 0.f);
#pragma unroll
            for (int ai = 0; ai < 2; ++ai)
#pragma unroll
                for (int m = 0; m < 4; ++m) {
                    const int row = row0 + ai * 128 + m * 16;
                    float v[8];
#pragma unroll
                    for (int e = 0; e < 8; ++e) v[e] = acc[ai][bj][m][e >> 2][e & 3] + bias[e];
                    if (kind == 0) {
#pragma unroll
                        for (int e = 0; e < 8; ++e) { const float sp = __logf(1.f + __expf(-v[e])); v[e] = -__expf(-sp - 0.5f); }
                        const int dir = c8 / 384, c = c8 % 384;
                        *(u32x4*)((u16*)(R + R_LD) + ((size_t)dir * M + row) * 384 + c) = (u32x4){pk_f16(v[0], v[1]), pk_f16(v[2], v[3]), pk_f16(v[4], v[5]), pk_f16(v[6], v[7])};
                    } else if (kind == 1) {
#pragma unroll
                        for (int e = 0; e < 8; ++e) v[e] = sigmoidf_(v[e]);
                        const int cc = c8 - 768, dir = cc / 384, c = cc % 384;
                        *(u32x4*)((u16*)(R + R_AA) + ((size_t)dir * M + row) * 384 + c) = (u32x4){pk_f16(v[0], v[1]), pk_f16(v[2], v[3]), pk_f16(v[4], v[5]), pk_f16(v[6], v[7])};
                    } else {
                        *(u32x4*)(MIX + (size_t)row * 1024 + 640 + (c8 - 1536)) = (u32x4){cvt_pk_bf16(v[0], v[1]), cvt_pk_bf16(v[2], v[3]), cvt_pk_bf16(v[4], v[5]), cvt_pk_bf16(v[6], v[7])};
                    }
                }
        }
    }
};

template <int KIND>
__device__ __forceinline__ void convert_wt(const Frame& F, const float* src, int K, int ldsrc, int ncols_valid, u16* dst, int nrows, int& task, int tbase, int tstride) {
    LAS float* tile = (LAS float*)F.lds;
    const int ntn = nrows / 64, ntk = K / 64, ntot = ntn * ntk;
    const int nl = F.tid & 63, kq = F.tid >> 6;
    float cur[8];
    auto tile_c0 = [&](int t, int& j0, int& k0) { const int tt = t - tbase, tn = tt % ntn, tk = tt / ntn; j0 = tn * 64; k0 = tk * 64;
        if (KIND == 1) { const int uu = j0 >> 8, w = j0 & 255; return (w < 128) ? uu * 128 + w : 2816 + uu * 128 + (w - 128); } return j0; };
    if (task < tbase + ntot) { int j0, k0; const int c0 = tile_c0(task, j0, k0);
#pragma unroll
        for (int i = 0; i < 8; ++i) { const int c = c0 + nl; cur[i] = (c < ncols_valid) ? src[(size_t)(k0 + kq * 8 + i) * ldsrc + c] : 0.f; } }
    for (; task < tbase + ntot; task += tstride) {
        int j0, k0; (void)tile_c0(task, j0, k0);
        float nxt[8];
        const int ntask = task + tstride;
        if (ntask < tbase + ntot) { int j1, k1; const int c1 = tile_c0(ntask, j1, k1);
#pragma unroll
            for (int i = 0; i < 8; ++i) { const int c = c1 + nl; nxt[i] = (c < ncols_valid) ? src[(size_t)(k1 + kq * 8 + i) * ldsrc + c] : 0.f; } }
        else {
#pragma unroll
            for (int i = 0; i < 8; ++i) nxt[i] = 0.f; }
#pragma unroll
        for (int i = 0; i < 8; ++i) tile[(kq * 8 + i) * 65 + nl] = cur[i];
        __syncthreads();
        { const int n = F.tid >> 3, kc = (F.tid & 7) * 8; float v[8];
#pragma unroll
          for (int i = 0; i < 8; ++i) v[i] = tile[(kc + i) * 65 + n];
          *(u32x4*)(dst + (size_t)(j0 + n) * K + k0 + kc) = (u32x4){cvt_pk_bf16(v[0], v[1]), cvt_pk_bf16(v[2], v[3]), cvt_pk_bf16(v[4], v[5]), cvt_pk_bf16(v[6], v[7])}; }
        __syncthreads();
#pragma unroll
        for (int i = 0; i < 8; ++i) cur[i] = nxt[i];
    }
}
__device__ __forceinline__ void phase_convert(const Frame& F, int l, int part, int vb, int nb) {
    unsigned char* W = F.ws + WS_W;
    int task = vb, base = 0;
    for (int s = 0; s < 2; ++s) {
        if (part == 0 || (part == 1) == (s == 0)) {
            convert_wt<1>(F, F.in[I_FWIN] + (size_t)(l * 2 + s) * 1024 * NIN, 1024, NIN, NIN, (u16*)(W + W_FIN) + (size_t)s * NIN * 1024, NIN, task, base, nb); base += (NIN / 64) * 16;
            convert_wt<0>(F, F.in[I_FWOUT] + (size_t)(l * 2 + s) * FF * 1024, FF, 1024, 1024, (u16*)(W + W_FOUT) + (size_t)s * 1024 * FF, 1024, task, base, nb); base += 16 * (FF / 64);
        }
    }
    if (part != 2) { convert_wt<0>(F, F.in[I_WMIN] + (size_t)l * 1024 * 3456, 1024, 3456, 3456, (u16*)(W + W_MIN), NMIXP, task, base, nb); base += (NMIXP / 64) * 16; }
    if (part != 1) { convert_wt<0>(F, F.in[I_WMOUT] + (size_t)l * 1024 * 1024, 1024, 1024, 1024, (u16*)(W + W_MOUT), 1024, task, base, nb); base += 16 * 16; }
    if (part != 2) {
        const float* wup = F.in[I_WUP] + (size_t)l * 2 * 64 * 384; const float* aup = F.in[I_AUP] + (size_t)l * 2 * 64 * 384; const float* gup = F.in[I_GUP] + (size_t)l * 128 * 384;
        u16* B2 = (u16*)(W + W_B2);
        for (int i = vb * 512 + F.tid; i < N2 * K2; i += nb * 512) {
            const int n = i / K2, k = i % K2; float v = 0.f;
            if (n < 384) { if (k < 64) v = wup[(0 * 64 + k) * 384 + n]; }
            else if (n < 768) { if (k >= 64 && k < 128) v = wup[(1 * 64 + (k - 64)) * 384 + (n - 384)]; }
            else if (n < 1152) { if (k >= 128 && k < 192) v = aup[(0 * 64 + (k - 128)) * 384 + (n - 768)]; }
            else if (n < 1536) { if (k >= 192 && k < 256) v = aup[(1 * 64 + (k - 192)) * 384 + (n - 1152)]; }
            else if (n < 1920) { if (k >= 256) v = gup[(k - 256) * 384 + (n - 1536)]; }
            B2[i] = (u16)(cvt_pk_bf16(v, 0.f) & 0xffffu);
        }
    }
}
__device__ __forceinline__ void phase_mod(const Frame& F, int l, int vb, int nb) {
    LAS float* red = (LAS float*)F.lds;
    float* MOD = (float*)(F.ws + WS_MOD);
    for (int task = vb; task < 144; task += nb) {
        const int cgp = task, cl = F.tid & 63, col = cgp * 64 + cl, kq = F.tid >> 6;
        float a0 = 0, a1 = 0, a2 = 0, a3 = 0, a4 = 0, a5 = 0;
        const float* w = F.in[I_WADA] + (size_t)l * 1024 * 9216 + col;
        const float* cp = F.in[I_CP]; const float* cs = F.in[I_CS];
#pragma unroll 16
        for (int k = kq * 128; k < kq * 128 + 128; ++k) {
            const float wv = w[(size_t)k * 9216];
            a0 += cp[k] * wv; a1 += cp[1024 + k] * wv; a2 += cs[k] * wv; a3 += cs[1024 + k] * wv; a4 += cs[2048 + k] * wv; a5 += cs[3072 + k] * wv;
        }
        LAS float* rp = red + (kq * 64 + cl) * 6;
        rp[0] = a0; rp[1] = a1; rp[2] = a2; rp[3] = a3; rp[4] = a4; rp[5] = a5;
        __syncthreads();
        if (F.tid < 384) { const int b = F.tid >> 6, cc = F.tid & 63; float s = 0.f;
#pragma unroll
            for (int q = 0; q < 8; ++q) s += red[(q * 64 + cc) * 6 + b];
            MOD[(size_t)(l * 6 + b) * 9216 + cgp * 64 + cc] = s + F.in[I_BADA][l * 9216 + cgp * 64 + cc]; }
        __syncthreads();
    }
}
__device__ __forceinline__ void phase_init(const Frame& F) {
    u16* H = (u16*)(F.ws + WS_H);
    for (int i = blockIdx.x * 512 + F.tid; i < M * 256; i += gridDim.x * 512) {
        const int row = i >> 8, c4 = (i & 255) * 4, b = row_batch(row);
        const float* xin = row < MPROMPT ? F.in[I_XP] + (size_t)row * D : F.in[I_XS] + (size_t)(row - MPROMPT) * D;
        const f32x4 v = *(const f32x4*)(xin + c4);
        const f32x4 sh = *(const f32x4*)(modp(F, 0, b, 0, 0) + c4), sc = *(const f32x4*)(modp(F, 0, b, 0, 1) + c4);
        const f32x4 h = v * (sc + 1.f) + sh;
        *(u32x2*)(H + (size_t)row * D + c4) = (u32x2){cvt_pk_bf16(h[0], h[1]), cvt_pk_bf16(h[2], h[3])};
    }
}
__device__ __forceinline__ void ln_row(const Frame& F, f32x4 (&v)[4], int row, const float* g, const float* bb, int nl, int ni, bool write_x, float* ST, u16* H) {
    float s = 0.f;
#pragma unroll
    for (int j = 0; j < 4; ++j) s += v[j][0] + v[j][1] + v[j][2] + v[j][3];
    const float mu = wave_sum(s) * (1.f / D);
    float q = 0.f;
#pragma unroll
    for (int j = 0; j < 4; ++j) { v[j] = v[j] - mu; q += v[j][0] * v[j][0] + v[j][1] * v[j][1] + v[j][2] * v[j][2] + v[j][3] * v[j][3]; }
    const float rstd = rsqrtf(wave_sum(q) * (1.f / D) + LN_EPS);
    const int b = row_batch(row);
    float* xp = F.X + (size_t)row * D;
    if (!write_x && F.lane == 0) *(f32x2*)(ST + (size_t)row * 2) = (f32x2){mu, rstd};
#pragma unroll
    for (int j = 0; j < 4; ++j) {
        const int c = j * 256 + F.lane * 4;
        const f32x4 y = v[j] * rstd * *(const f32x4*)(g + c) + *(const f32x4*)(bb + c);
        if (write_x) *(f32x4*)(xp + c) = y;
        if (nl >= 0) {
            const f32x4 sh = *(const f32x4*)(modp(F, nl, b, ni, 0) + c), sc = *(const f32x4*)(modp(F, nl, b, ni, 1) + c);
            const f32x4 h = y * (sc + 1.f) + sh;
            *(u32x2*)(H + (size_t)row * D + c) = (u32x2){cvt_pk_bf16(h[0], h[1]), cvt_pk_bf16(h[2], h[3])};
        }
    }
}
__device__ __forceinline__ void phase_ln(const Frame& F, int l, int i, int nl, int ni, bool write_x) {
    float* ST = (float*)(F.ws + WS_STATS);
    u16* H = (u16*)(F.ws + WS_H);
    const float* g = F.in[I_LNG] + (size_t)(l * 3 + i) * D; const float* bb = F.in[I_LNB] + (size_t)(l * 3 + i) * D;
    const int stride = gridDim.x * 8;
    int row = blockIdx.x * 8 + F.wave;
    f32x4 va[4], vb[4], na[4], nb_[4];
    if (row < M) {
        const int r2 = row + stride < M ? row + stride : row;
#pragma unroll
        for (int j = 0; j < 4; ++j) { va[j] = *(const f32x4*)(F.X + (size_t)row * D + j * 256 + F.lane * 4); vb[j] = *(const f32x4*)(F.X + (size_t)r2 * D + j * 256 + F.lane * 4); }
    }
#pragma unroll 1
    for (; row < M; row += 2 * stride) {
        const int rowb = row + stride;
        const int nra = row + 2 * stride < M ? row + 2 * stride : row, nrb = row + 3 * stride < M ? row + 3 * stride : row;
#pragma unroll
        for (int j = 0; j < 4; ++j) { na[j] = *(const f32x4*)(F.X + (size_t)nra * D + j * 256 + F.lane * 4); nb_[j] = *(const f32x4*)(F.X + (size_t)nrb * D + j * 256 + F.lane * 4); }
        ln_row(F, va, row, g, bb, nl, ni, write_x, ST, H);
        if (rowb < M) ln_row(F, vb, rowb, g, bb, nl, ni, write_x, ST, H);
#pragma unroll
        for (int j = 0; j < 4; ++j) { va[j] = na[j]; vb[j] = nb_[j]; }
    }
}

__device__ __forceinline__ void load8h(const u16* p, bool ok, float* o) {
    u32x4 v = ok ? *(const u32x4*)p : (u32x4){0u, 0u, 0u, 0u};
#pragma unroll
    for (int e = 0; e < 4; ++e) { o[2 * e] = hlo(v[e]); o[2 * e + 1] = hhi(v[e]); }
}

__device__ __forceinline__ void phase_conv_a2(const Frame& F, int l) {
    u16* MIX = (u16*)(F.ws + WS_H); u16* A2 = (u16*)(F.ws + WS_A2);
    const u16* CV = (const u16*)(F.ws + WS_R + R_CONV); const u16* ZL = (const u16*)(F.ws + WS_R + R_ZLAT);
    const float* cw = F.in[I_CONVW] + (size_t)l * 3 * 256; const float* mu = F.in[I_MU] + (size_t)l * 1536 + 1152;
    const int nth = gridDim.x * 512, gt = blockIdx.x * 512 + F.tid;
#pragma unroll 2
    for (int i = gt; i < M * 32; i += nth) {
        const int row = i >> 5, c = (i & 31) * 8; int S, t; row_info(row, S, t);
        const u16* p = CV + (size_t)row * 768 + c;
        float gb[8], u0[8], u1[8], u2[8], a[8], b[8];
        load8h(p, true, gb);
        load8h(p + 256, true, a); load8h(p + 512, true, b);
#pragma unroll
        for (int e = 0; e < 8; ++e) u1[e] = a[e] * b[e];
        load8h(p - 768 + 256, t > 0, a); load8h(p - 768 + 512, t > 0, b);
#pragma unroll
        for (int e = 0; e < 8; ++e) u0[e] = a[e] * b[e];
        load8h(p + 768 + 256, t < S - 1, a); load8h(p + 768 + 512, t < S - 1, b);
#pragma unroll
        for (int e = 0; e < 8; ++e) u2[e] = a[e] * b[e];
        float y[8];
#pragma unroll
        for (int e = 0; e < 8; ++e) y[e] = gb[e] * (cw[c + e] * u0[e] + cw[256 + c + e] * u1[e] + cw[512 + c + e] * u2[e]);
        *(u32x4*)(MIX + (size_t)row * 1024 + 384 + c) = (u32x4){cvt_pk_bf16(y[0], y[1]), cvt_pk_bf16(y[2], y[3]), cvt_pk_bf16(y[4], y[5]), cvt_pk_bf16(y[6], y[7])};
    }
#pragma unroll 2
    for (int i = gt; i < M * 48; i += nth) {
        const int row = i / 48, c = (i % 48) * 8; int S, t; row_info(row, S, t);
        const u16* p = ZL + (size_t)row * 384 + c;
        float z[8], zm[8], zp[8], y[8];
        load8h(p, true, z); load8h(p - 384, t > 0, zm); load8h(p + 384, t < S - 1, zp);
#pragma unroll
        for (int e = 0; e < 8; ++e) { const float zs = z[e] + mu[c + e] * (0.5f * (zm[e] + zp[e]) - z[e]); y[e] = c < 128 ? (1.f - 2.f * __builtin_amdgcn_rcpf(1.f + __expf(2.f * zs))) : (c < 256 ? zs : sigmoidf_(zs)); }
        *(u32x4*)(A2 + (size_t)row * 384 + c) = (u32x4){cvt_pk_bf16(y[0], y[1]), cvt_pk_bf16(y[2], y[3]), cvt_pk_bf16(y[4], y[5]), cvt_pk_bf16(y[6], y[7])};
    }
    {
        const u16* ZR = (const u16*)(F.ws + WS_R + R_ZRKV); float* INV = (float*)(F.ws + WS_INV);
        const float* muk = F.in[I_MU] + (size_t)l * 1536 + 384; const float* kkp = F.in[I_KK] + (size_t)l * 384;
#pragma unroll 2
        for (int i = gt; i < M * 48; i += nth) {
            const int item = i >> 3, sub = i & 7, row = item / 6, head = item % 6, c = head * 64 + sub * 8; int S, t; row_info(row, S, t);
            const u16* p = ZR + (size_t)row * 1152 + 384 + c;
            float z[8], zm[8], zp[8];
            load8h(p, true, z); load8h(p - 1152, t > 0, zm); load8h(p + 1152, t < S - 1, zp);
            float q = 0.f;
#pragma unroll
            for (int e = 0; e < 8; ++e) { const float ks = (z[e] + muk[c + e] * (0.5f * (zm[e] + zp[e]) - z[e])) * kkp[c + e]; q += ks * ks; }
            q = allreduce8(q);
            if (sub == 0) INV[(size_t)row * 6 + head] = rsqrtf(fmaxf(q, 1e-24f));
        }
    }
}

__device__ __forceinline__ void att_group(int gi, int& sh, int& g) { if (gi < 12) { sh = 0; g = gi; } else if (gi < 18) { sh = 2; g = gi - 12; } else { sh = 4; g = gi - 18; } }
__device__ __forceinline__ void phase_attn(const Frame& F) {
    LAS float* biasTab = (LAS float*)F.lds;
    LAS u16* vst = (LAS u16*)(F.lds + 16384) + F.wave * (32 * 72);
    const u16* QKV = (const u16*)(F.ws + WS_R + R_QKV); u16* MIX = (u16*)(F.ws + WS_H);
    const float* relb = F.in[I_RELB];
    for (int i = F.tid; i < 3 * 6 * 129; i += 512) {
        const int br = i / (6 * 129), h = (i / 129) % 6, rel = i % 129 - 64, d = br == 0 ? 1 : (br == 1 ? 4 : 16), x = rel * d, n = x < 0 ? -x : x;
        int bk = n < 8 ? n : 8 + (n >= 15) + (n >= 27) + (n >= 50) + (n >= 91) + (n >= 166) + (n >= 305) + (n >= 559);
        if (x > 0) bk += 16;
        biasTab[(br * 6 + h) * 132 + rel + 64] = relb[bk * 6 + h];
    }
    __syncthreads();
    const int lane = F.lane, qi = lane & 15, gq = lane >> 4;
    const int vb = (gridDim.x & 7) == 0 ? (int)(blockIdx.x & 7) * (int)(gridDim.x >> 3) + (int)(blockIdx.x >> 3) : (int)blockIdx.x;
    for (int item = vb * 8 + F.wave; item < 12288; item += gridDim.x * 8) {
        const int r = item & 15, head = (item >> 4) >> 7, stl = (item >> 4) & 127;
        int m0, S, ib;
        if (stl < 64) { m0 = (stl >> 5) * 8192; S = 8192; ib = stl & 31; } else { const int s2 = stl - 64; m0 = MPROMPT + (s2 >> 4) * 4096; S = 4096; ib = s2 & 15; }
        const int pq0 = r + 256 * ib, pq = pq0 + 16 * qi;
        const u16* qp = QKV + (size_t)(m0 + pq) * 1152 + head * 64 + gq * 8;
        const bf16x8 Q0 = *(const bf16x8*)qp, Q1 = *(const bf16x8*)(qp + 32);
        const char* Kb = (const char*)(QKV + (size_t)m0 * 1152 + 384 + head * 64);
        const char* Vb = (const char*)(QKV + (size_t)m0 * 1152 + 768 + head * 64);
        float m_run = -1e30f, l_part = 0.f;
        f32x4 O[4];
#pragma unroll
        for (int n = 0; n < 4; ++n) O[n] = (f32x4){0.f, 0.f, 0.f, 0.f};
        bf16x8 kn[2][2]; u32x4 vn[4];
        {
            int sh, g; att_group(0, sh, g); const int L = S >> sh, rd = r & ((1 << sh) - 1), kb = (pq0 >> sh) - 64 + 32 * g;
#pragma unroll
            for (int tt = 0; tt < 2; ++tt) { int ik = kb + 16 * tt + qi; ik = ik < 0 ? 0 : (ik >= L ? L - 1 : ik); const char* kp = Kb + (unsigned)((rd + (ik << sh)) * 2304 + gq * 16); kn[tt][0] = *(const bf16x8*)kp; kn[tt][1] = *(const bf16x8*)(kp + 64); }
#pragma unroll
            for (int j = 0; j < 4; ++j) { int ik = kb + (lane >> 3) + 8 * j; ik = ik < 0 ? 0 : (ik >= L ? L - 1 : ik); vn[j] = *(const u32x4*)(Vb + (unsigned)((rd + (ik << sh)) * 2304 + (lane & 7) * 16)); }
        }
        for (int gi = 0; gi < 23; ++gi) {
            int sh, g; att_group(gi, sh, g);
            const int L = S >> sh, kb = (pq0 >> sh) - 64 + 32 * g, iq = pq >> sh;
            const int br = sh >> 1;
            bf16x8 kc[2][2]; u32x4 vc[4];
#pragma unroll
            for (int tt = 0; tt < 2; ++tt) { kc[tt][0] = kn[tt][0]; kc[tt][1] = kn[tt][1]; }
#pragma unroll
            for (int j = 0; j < 4; ++j) vc[j] = vn[j];
            {
                int sh2, g2; att_group(gi < 22 ? gi + 1 : gi, sh2, g2); const int L2 = S >> sh2, rd2 = r & ((1 << sh2) - 1), kb2 = (pq0 >> sh2) - 64 + 32 * g2;
#pragma unroll
                for (int tt = 0; tt < 2; ++tt) { int ik = kb2 + 16 * tt + qi; ik = ik < 0 ? 0 : (ik >= L2 ? L2 - 1 : ik); const char* kp = Kb + (unsigned)((rd2 + (ik << sh2)) * 2304 + gq * 16); kn[tt][0] = *(const bf16x8*)kp; kn[tt][1] = *(const bf16x8*)(kp + 64); }
#pragma unroll
                for (int j = 0; j < 4; ++j) { int ik = kb2 + (lane >> 3) + 8 * j; ik = ik < 0 ? 0 : (ik >= L2 ? L2 - 1 : ik); vn[j] = *(const u32x4*)(Vb + (unsigned)((rd2 + (ik << sh2)) * 2304 + (lane & 7) * 16)); }
            }
#pragma unroll
            for (int j = 0; j < 4; ++j) *(LAS u32x4*)(vst + ((lane >> 3) + 8 * j) * 72 + (lane & 7) * 8) = vc[j];
            float s[8], bv[8];
            const int relb = kb + 4 * gq - iq;
            const LAS float* bt = biasTab + (br * 6 + head) * 132;
#pragma unroll
            for (int j = 0; j < 8; ++j) { int ri = relb + 16 * (j >> 2) + (j & 3) + 64; ri = ri < 0 ? 0 : (ri > 128 ? 128 : ri); bv[j] = bt[ri]; }
#pragma unroll
            for (int j = 0; j < 8; ++j) asm volatile("" : "+v"(bv[j]));
#pragma unroll
            for (int tt = 0; tt < 2; ++tt) {
                f32x4 st = (f32x4){0.f, 0.f, 0.f, 0.f};
                st = __builtin_amdgcn_mfma_f32_16x16x32_bf16(kc[tt][0], Q0, st, 0, 0, 0);
                st = __builtin_amdgcn_mfma_f32_16x16x32_bf16(kc[tt][1], Q1, st, 0, 0, 0);
#pragma unroll
                for (int e = 0; e < 4; ++e) {
                    const int rel = relb + 16 * tt + e, ik = rel + iq;
                    const bool valid = ((unsigned)(rel + 64) <= 128u) && ((unsigned)ik < (unsigned)L);
                    s[tt * 4 + e] = valid ? st[e] * 0.125f + bv[tt * 4 + e] : -INFINITY;
                }
            }
            float gmax = s[0];
#pragma unroll
            for (int e = 1; e < 8; ++e) gmax = fmaxf(gmax, s[e]);
            gmax = fmaxf(gmax, __shfl_xor(gmax, 16, 64)); gmax = fmaxf(gmax, __shfl_xor(gmax, 32, 64));
            const float mnew = fmaxf(m_run, gmax), alpha = __expf(m_run - mnew);
            m_run = mnew;
            float p[8], ps = 0.f;
#pragma unroll
            for (int e = 0; e < 8; ++e) { p[e] = __expf(s[e] - mnew); ps += p[e]; }
            l_part = l_part * alpha + ps;
            bf16x8 Pf;
            { const unsigned a = cvt_pk_bf16(p[0], p[1]), b = cvt_pk_bf16(p[2], p[3]), c = cvt_pk_bf16(p[4], p[5]), dd = cvt_pk_bf16(p[6], p[7]); u32x4 t4 = {a, b, c, dd}; Pf = __builtin_bit_cast(bf16x8, t4); }
#pragma unroll
            for (int n = 0; n < 4; ++n) {
                O[n] = O[n] * alpha;
                const s16x4 v0 = __builtin_amdgcn_ds_read_tr16_b64_v4i16((LAS s16x4*)(vst + (4 * gq + (qi >> 2)) * 72 + 16 * n + 4 * (qi & 3)));
                const s16x4 v1 = __builtin_amdgcn_ds_read_tr16_b64_v4i16((LAS s16x4*)(vst + (16 + 4 * gq + (qi >> 2)) * 72 + 16 * n + 4 * (qi & 3)));
                const bf16x8 Vf = {v0[0], v0[1], v0[2], v0[3], v1[0], v1[1], v1[2], v1[3]};
                O[n] = __builtin_amdgcn_mfma_f32_16x16x32_bf16(Vf, Pf, O[n], 0, 0, 0);
            }
        }
        float lt = l_part; lt += __shfl_xor(lt, 16, 64); lt += __shfl_xor(lt, 32, 64);
        const float inv = 1.f / lt;
        u16* op = MIX + (size_t)(m0 + pq) * 1024 + head * 64 + 4 * gq;
#pragma unroll
        for (int n = 0; n < 4; ++n) { const f32x4 o = O[n] * inv; *(u32x2*)(op + 16 * n) = (u32x2){cvt_pk_bf16(o[0], o[1]), cvt_pk_bf16(o[2], o[3])}; }
    }
}

constexpr int SC_T = 32, SC_BUF = 43008, SC_YB = 86016;
struct PrepRegs { unsigned zr[10], zk[10], zv[10], aa[8], ld[8]; float inv[8]; };
__device__ __forceinline__ void prep_load(const Frame& F, int m0, int S, int dir, int head, int chunk, PrepRegs& P) {
    const int pw = F.wave - 4, k = F.lane;
    const u16* ZR = (const u16*)(F.ws + WS_R + R_ZRKV);
    const u16* LD = (const u16*)(F.ws + WS_R + R_LD) + (size_t)dir * M * 384; const u16* AAp = (const u16*)(F.ws + WS_R + R_AA) + (size_t)dir * M * 384;
    const int n0 = chunk * SC_T + pw * 8;
    const int tlo = dir ? (S - 1 - n0 - 7) : n0;
#pragma unroll
    for (int j = 0; j < 10; ++j) {
        int t = tlo - 1 + j; t = t < 0 ? 0 : (t >= S ? S - 1 : t);
        const u16* p = ZR + (size_t)(m0 + t) * 1152 + head * 64 + k;
        P.zr[j] = p[0]; P.zk[j] = p[384]; P.zv[j] = p[768];
    }
#pragma unroll
    for (int u = 0; u < 8; ++u) { const size_t ro = (size_t)(m0 + tlo + u) * 384 + head * 64 + k; P.aa[u] = AAp[ro]; P.ld[u] = LD[ro]; P.inv[u] = ((const float*)(F.ws + WS_INV))[(size_t)(m0 + tlo + u) * 6 + head]; }
}
__device__ __forceinline__ void prep_compute(const Frame& F, int S, int dir, int rq, int chunk, LAS unsigned char* buf, const PrepRegs& P, float mur, float muk, float muv, float kkc, float kac) {
    const int pw = F.wave - 4, k = F.lane;
    const int n0 = chunk * SC_T + pw * 8;
    const int tlo = dir ? (S - 1 - n0 - 7) : n0;
    float zr[10], zk[10], zv[10];
#pragma unroll
    for (int j = 0; j < 10; ++j) { zr[j] = h2f((u16)P.zr[j]); zk[j] = h2f((u16)P.zk[j]); zv[j] = h2f((u16)P.zv[j]); }
    if (tlo - 1 < 0) { zr[0] = 0.f; zk[0] = 0.f; zv[0] = 0.f; }
    if (tlo + 8 >= S) { zr[9] = 0.f; zk[9] = 0.f; zv[9] = 0.f; }
    float ldv[8], pre[8], suf[8];
#pragma unroll
    for (int u = 0; u < 8; ++u) ldv[u] = h2f((u16)P.ld[u]);
    pre[0] = ldv[0]; suf[7] = ldv[7];
#pragma unroll
    for (int u = 1; u < 8; ++u) { pre[u] = pre[u - 1] + ldv[u]; suf[7 - u] = suf[8 - u] + ldv[7 - u]; }
    LAS float* Ab = (LAS float*)buf; LAS float* Bb = Ab + 2048; LAS float* Kb = Ab + 4096; LAS float* Rb = Ab + 6144; LAS float* WBb = Ab + 8192; LAS float* Vb = Ab + 10240;
    float Wc[8];
#pragma unroll
    for (int u = 0; u < 8; ++u) Wc[u] = __expf(dir ? suf[u] : pre[u]);
#pragma unroll
    for (int u = 0; u < 8; ++u) {
        const int sp = pw * 8 + (dir ? 7 - u : u);
        const float rs = zr[u + 1] + mur * (0.5f * (zr[u] + zr[u + 2]) - zr[u + 1]);
        const float ks = zk[u + 1] + muk * (0.5f * (zk[u] + zk[u + 2]) - zk[u + 1]);
        const float vs = zv[u + 1] + muv * (0.5f * (zv[u] + zv[u + 2]) - zv[u + 1]);
        const float kk = ks * kkc * P.inv[u];
        const float a = h2f((u16)P.aa[u]);
        const float Wi = __builtin_amdgcn_rcpf(Wc[u]);
        const float Wp = dir ? (u == 7 ? 1.f : Wc[u < 7 ? u + 1 : 7]) : (u == 0 ? 1.f : Wc[u > 0 ? u - 1 : 0]);
        Ab[sp * 64 + k] = Wp * kk; Bb[sp * 64 + k] = -(kk * a) * Wi; Kb[sp * 64 + k] = ks * (1.f + (a - 1.f) * kac) * Wi; Rb[sp * 64 + k] = rs * Wc[u];
        if (u == (dir ? 0 : 7)) WBb[pw * 64 + k] = Wc[u];
        if ((k >> 4) == rq) Vb[(k & 15) * 32 + sp] = vs;
    }
}
__device__ __forceinline__ void scan_flush(const Frame& F, int m0, int S, int dir, int head, int rq, int chunk, LAS float* yb) {
    u16* YS = (u16*)(F.ws + WS_R + R_YS) + (size_t)dir * M * 384;
    const int j = F.tid - 256, s = j >> 3, pr = j & 7, n = chunk * SC_T + s, t = dir ? S - 1 - n : n;
    const float y0 = yb[s * 16 + pr * 2], y1 = yb[s * 16 + pr * 2 + 1];
    *(unsigned*)(YS + (size_t)(m0 + t) * 384 + head * 64 + rq * 16 + pr * 2) = cvt_pk_bf16(y0, y1);
}
__device__ __forceinline__ void scan_item(const Frame& F, int l, int seq, int dir, int head, int rq) {
    int m0, S;
    if (seq < 2) { m0 = seq * 8192; S = 8192; } else { m0 = MPROMPT + (seq - 2) * 4096; S = 4096; }
    const int nch = S / SC_T;
    const bool prep = F.wave >= 4;
    float mur = 0.f, muk = 0.f, muv = 0.f, kkc = 0.f, kac = 0.f;
    if (prep) { const float* mu = F.in[I_MU] + (size_t)l * 1536 + head * 64 + F.lane; mur = mu[0]; muk = mu[384]; muv = mu[768];
        kkc = F.in[I_KK][l * 384 + head * 64 + F.lane]; kac = F.in[I_KA][l * 384 + head * 64 + F.lane]; }
    __syncthreads();
    f32x4 st = (f32x4){0.f, 0.f, 0.f, 0.f};
    const int rl = F.wave * 4 + (F.lane >> 4), ks4 = (F.lane & 15) * 4;
    if (!prep) __builtin_amdgcn_s_setprio(2);
    if (prep) {
        PrepRegs P0, P1;
        prep_load(F, m0, S, dir, head, 0, P0);
#pragma unroll 1
        for (int c = -1; c <= nch; c += 2) {
            if (c >= 1) scan_flush(F, m0, S, dir, head, rq, c - 1, (LAS float*)(F.lds + SC_YB) + ((c - 1) & 1) * 512);
            if (c + 1 < nch) {
                prep_load(F, m0, S, dir, head, (c + 2 < nch) ? c + 2 : c + 1, P1);
                prep_compute(F, S, dir, rq, c + 1, F.lds + ((c + 1) & 1) * SC_BUF, P0, mur, muk, muv, kkc, kac);
            }
            __syncthreads();
            if (c >= 0) scan_flush(F, m0, S, dir, head, rq, c, (LAS float*)(F.lds + SC_YB) + (c & 1) * 512);
            if (c + 2 < nch) {
                prep_load(F, m0, S, dir, head, (c + 3 < nch) ? c + 3 : c + 2, P0);
                prep_compute(F, S, dir, rq, c + 2, F.lds + ((c + 2) & 1) * SC_BUF, P1, mur, muk, muv, kkc, kac);
            }
            __syncthreads();
        }
    } else {
#pragma unroll 1
    for (int c = -1; c <= nch; ++c) {
        if (c >= 0 && c < nch) {
            LAS float* Wb = (LAS float*)(F.lds + (c & 1) * SC_BUF);
            LAS float* yb = (LAS float*)(F.lds + SC_YB) + (c & 1) * 512;
            const int ln = F.lane;
            const bool b0 = ln & 1, b1 = ln & 2, b2 = ln & 4, b3 = ln & 8;
            const int jst = ((ln >> 2) & 1) * 8 + ((ln >> 3) & 1) * 4 + (ln & 3);
            f32x4 al4 = *(LAS f32x4*)(Wb + ks4), be4 = *(LAS f32x4*)(Wb + 2048 + ks4), ka4 = *(LAS f32x4*)(Wb + 4096 + ks4), r4 = *(LAS f32x4*)(Wb + 6144 + ks4);
            f32x4 al4a = *(LAS f32x4*)(Wb + 64 + ks4), be4a = *(LAS f32x4*)(Wb + 2048 + 64 + ks4), ka4a = *(LAS f32x4*)(Wb + 4096 + 64 + ks4), r4a = *(LAS f32x4*)(Wb + 6144 + 64 + ks4);
#pragma unroll 1
            for (int s0 = 0; s0 < SC_T; s0 += 16) {
                float po[16];
                f32x4 vv[4];
#pragma unroll
                for (int q = 0; q < 4; ++q) vv[q] = *(LAS f32x4*)(Wb + 10240 + rl * 32 + s0 + 4 * q);
                const f32x4 wb0 = *(LAS f32x4*)(Wb + 8192 + (s0 >> 3) * 64 + ks4), wb1 = *(LAS f32x4*)(Wb + 8192 + ((s0 >> 3) + 1) * 64 + ks4);
#pragma unroll
                for (int j = 0; j < 16; ++j) {
                    const int sn = (s0 + j + 2) & (SC_T - 1);
                    const f32x4 al4n = *(LAS f32x4*)(Wb + sn * 64 + ks4), be4n = *(LAS f32x4*)(Wb + 2048 + sn * 64 + ks4), ka4n = *(LAS f32x4*)(Wb + 4096 + sn * 64 + ks4), r4n = *(LAS f32x4*)(Wb + 6144 + sn * 64 + ks4);
                    const float v = vv[j >> 2][j & 3];
                    f32x2 p = (f32x2){st[0], st[1]} * (f32x2){al4[0], al4[1]}; p = (f32x2){st[2], st[3]} * (f32x2){al4[2], al4[3]} + p;
                    st = ka4 * v + st;
                    const float sa = allreduce16(p[0] + p[1]);
                    st = be4 * sa + st;
                    f32x2 q = (f32x2){st[0], st[1]} * (f32x2){r4[0], r4[1]}; q = (f32x2){st[2], st[3]} * (f32x2){r4[2], r4[3]} + q;
                    po[j] = q[0] + q[1];
                    if (j == 7) st = st * wb0;
                    if (j == 15) st = st * wb1;
                    al4 = al4a; be4 = be4a; ka4 = ka4a; r4 = r4a;
                    al4a = al4n; be4a = be4n; ka4a = ka4n; r4a = r4n;
                }
                float q1[8], q2[4], q3[2];
#pragma unroll
                for (int m = 0; m < 8; ++m) { const float keep = b0 ? po[2 * m + 1] : po[2 * m], give = b0 ? po[2 * m] : po[2 * m + 1]; q1[m] = keep + dpp_mov<0xB1, 0xF>(0.f, give); }
#pragma unroll
                for (int m = 0; m < 4; ++m) { const float keep = b1 ? q1[2 * m + 1] : q1[2 * m], give = b1 ? q1[2 * m] : q1[2 * m + 1]; q2[m] = keep + dpp_mov<0x4E, 0xF>(0.f, give); }
#pragma unroll
                for (int m = 0; m < 2; ++m) { const float keep = b3 ? q2[2 * m + 1] : q2[2 * m], give = b3 ? q2[2 * m] : q2[2 * m + 1]; q3[m] = keep + dpp_mov<0x128, 0xF>(0.f, give); }
                { const float keep = b2 ? q3[1] : q3[0], give = b2 ? q3[0] : q3[1];
                  float rcv = dpp_mov<0x104, 0x5>(0.f, give);
                  rcv = dpp_mov<0x114, 0xA>(rcv, give);
                  yb[(s0 + jst) * 16 + rl] = keep + rcv; }
            }
        }
        __syncthreads();
    }
    }
    __builtin_amdgcn_s_setprio(0);
}
__device__ __forceinline__ void phase_scan(const Frame& F, int l) {
    const int b = blockIdx.x, G = gridDim.x;
    const bool fast = G >= 192;
    const int nit = fast ? (b < 96 ? 1 : (b < 192 ? 2 : 0)) : (b < 288 ? (288 - b + G - 1) / G : 0);
#pragma unroll 1
    for (int it = 0; it < nit; ++it) {
        int seq, dir, head, rq;
        if (fast) {
            if (b < 96) { const int xcd = b & 7, j = b >> 3, c = (j >> 2) * 8 + xcd; rq = j & 3; seq = c / 12; dir = (c / 6) & 1; head = c % 6; }
            else { const int bb = b - 96, xcd = bb & 7, jj = (bb >> 3) * 2 + it, c = (jj >> 2) * 8 + xcd; rq = jj & 3; seq = 2 + c / 12; dir = (c / 6) & 1; head = c % 6; }
        } else {
            const int id = b + it * G, c = id >> 2; rq = id & 3;
            if (c < 24) { seq = c / 12; dir = (c / 6) & 1; head = c % 6; } else { const int c2 = c - 24; seq = 2 + c2 / 12; dir = (c2 / 6) & 1; head = c2 % 6; }
        }
        scan_item(F, l, seq, dir, head, rq);
    }
}
__device__ __forceinline__ void load8b(const u16* p, float* o) {
    const u32x4 v = *(const u32x4*)p;
#pragma unroll
    for (int e = 0; e < 4; ++e) { o[2 * e] = __uint_as_float(v[e] << 16); o[2 * e + 1] = __uint_as_float(v[e] & 0xffff0000u); }
}
__device__ __forceinline__ void phase_fin(const Frame& F, int l) {
    u16* MIX = (u16*)(F.ws + WS_H);
    const u16* YS = (const u16*)(F.ws + WS_R + R_YS); const u16* ZR = (const u16*)(F.ws + WS_R + R_ZRKV);
    const int sub = F.lane & 7;
#pragma unroll 2
    for (int it8 = blockIdx.x * 8 + F.wave; it8 < M * 6 / 8; it8 += gridDim.x * 8) {
        const int item = it8 * 8 + (F.lane >> 3), row = item / 6, head = item % 6, c = head * 64 + sub * 8; int S, t; row_info(row, S, t);
        float y[8], yb[8];
        load8b(YS + (size_t)row * 384 + c, y); load8b(YS + ((size_t)M + row) * 384 + c, yb);
        float s = 0.f;
#pragma unroll
        for (int e = 0; e < 8; ++e) { y[e] += yb[e]; s += y[e]; }
        const float ym = allreduce8(s) * (1.f / 64.f);
        float q = 0.f;
#pragma unroll
        for (int e = 0; e < 8; ++e) { y[e] -= ym; q += y[e] * y[e]; }
        const float rs_ = rsqrtf(allreduce8(q) * (1.f / 64.f) + GN_EPS);
        const u16* p = ZR + (size_t)row * 1152 + c; const float* mu = F.in[I_MU] + (size_t)l * 1536 + c;
        const bool okm = t > 0, okp = t < S - 1;
        float z0[8], zm[8], zp[8], rsv[8], ksv[8], vsv[8];
        load8h(p, true, z0); load8h(p - 1152, okm, zm); load8h(p + 1152, okp, zp);
#pragma unroll
        for (int e = 0; e < 8; ++e) rsv[e] = z0[e] + mu[e] * (0.5f * (zm[e] + zp[e]) - z0[e]);
        load8h(p + 384, true, z0); load8h(p + 384 - 1152, okm, zm); load8h(p + 384 + 1152, okp, zp);
#pragma unroll
        for (int e = 0; e < 8; ++e) ksv[e] = z0[e] + mu[384 + e] * (0.5f * (zm[e] + zp[e]) - z0[e]);
        load8h(p + 768, true, z0); load8h(p + 768 - 1152, okm, zm); load8h(p + 768 + 1152, okp, zp);
#pragma unroll
        for (int e = 0; e < 8; ++e) vsv[e] = z0[e] + mu[768 + e] * (0.5f * (zm[e] + zp[e]) - z0[e]);
        float bs = 0.f;
#pragma unroll
        for (int e = 0; e < 8; ++e) bs += rsv[e] * ksv[e] * F.in[I_RK][l * 384 + c + e];
        const float bon = allreduce8(bs);
        u16* mp = MIX + (size_t)row * 1024 + 640 + c;
        float g[8]; load8b(mp, g);
        float o[8];
#pragma unroll
        for (int e = 0; e < 8; ++e) o[e] = (y[e] * rs_ * F.in[I_GNG][l * 384 + c + e] + F.in[I_GNB][l * 384 + c + e] + bon * vsv[e]) * g[e];
        *(u32x4*)mp = (u32x4){cvt_pk_bf16(o[0], o[1]), cvt_pk_bf16(o[2], o[3]), cvt_pk_bf16(o[4], o[5]), cvt_pk_bf16(o[6], o[7])};
    }
}


#define XB_TMO      128
#define XB_XCNT(j)  (256  + 64 * (j))
#define XB_XSUB(j)  (1280 + 64 * (j))
#define XB_XGEN(j)  (2304 + 64 * (j))
#define XB_TOP      3328
#define XB_TOPGEN   3392
#define XCD_BAR_WORDS 3456
#define XB_SPIN_CAP (1u << 22)
__device__ __forceinline__ unsigned xb_ld(unsigned* p)              { return __hip_atomic_load(p, __ATOMIC_RELAXED, __HIP_MEMORY_SCOPE_AGENT); }
__device__ __forceinline__ unsigned xb_add(unsigned* p, unsigned v) { return __hip_atomic_fetch_add(p, v, __ATOMIC_RELAXED, __HIP_MEMORY_SCOPE_AGENT); }
__device__ __forceinline__ unsigned xb_xcc_id() { return (unsigned)__builtin_amdgcn_s_getreg((3 << 11) | 20) & 0xFu; }
#define XB_SPIN(cond, bar) do { unsigned _sp = 0; while (cond) { __builtin_amdgcn_s_sleep(1); \
    if ((++_sp & 255u) == 0u) { if (xb_ld(&(bar)[XB_TMO])) break; if (_sp > XB_SPIN_CAP) { atomicAdd(&(bar)[XB_TMO], 1u); break; } } } } while (0)
struct XcdBarrier { unsigned* bar; unsigned x; volatile LAS unsigned* st; };
__device__ __forceinline__ XcdBarrier xcd_barrier_post(unsigned* bar, volatile LAS unsigned* st) {
    XcdBarrier b; b.bar = bar; b.x = xb_xcc_id(); b.st = st;
    if (threadIdx.x == 0) (void)xb_add(&bar[XB_XCNT(b.x)], 1u);
    return b;
}
__device__ __forceinline__ void xcd_barrier_complete(unsigned* bar, unsigned x, unsigned& nloc, unsigned& nx) {
    const unsigned G = gridDim.x * gridDim.y * gridDim.z;
    unsigned sum, cnt, mine, sp = 0u;
    for (;;) {
        sum = 0u; cnt = 0u; mine = 0u;
#pragma unroll
        for (unsigned j = 0; j < 16; ++j) { const unsigned c = xb_ld(&bar[XB_XCNT(j)]); sum += c; cnt += (c > 0u) ? 1u : 0u; mine = (j == x) ? c : mine; }
        if (sum == G) break;
        __builtin_amdgcn_s_sleep(1);
        if ((++sp & 255u) == 0u) { if (xb_ld(&bar[XB_TMO])) break; if (sp > XB_SPIN_CAP) { atomicAdd(&bar[XB_TMO], 1u); break; } }
    }
    nloc = mine > 0u ? mine : 1u; nx = cnt > 0u ? cnt : 1u;
}
__device__ __forceinline__ void xcd_barrier(const XcdBarrier& b) {
    asm volatile("s_waitcnt vmcnt(0)" ::: "memory");
    __syncthreads();
    if (threadIdx.x == 0) {
        unsigned* bar = b.bar;
        __builtin_amdgcn_s_waitcnt(0);
        unsigned nloc = b.st[0], nx = b.st[1];
        if (nloc == 0u) { xcd_barrier_complete(bar, b.x, nloc, nx); b.st[0] = nloc; b.st[1] = nx; }
        const unsigned old = xb_add(&bar[XB_XSUB(b.x)], 1u);
        const unsigned gen = old / nloc;
        if (old + 1u == (gen + 1u) * nloc) {
            __builtin_amdgcn_fence(__ATOMIC_RELEASE, "agent");
            asm volatile("s_waitcnt vmcnt(0)" ::: "memory");
            const unsigned og = xb_add(&bar[XB_TOP], 1u);
            const unsigned tg = og / nx;
            if (og + 1u == (tg + 1u) * nx) xb_add(&bar[XB_TOPGEN], 1u);
            else XB_SPIN(xb_ld(&bar[XB_TOPGEN]) == tg, bar);
            __builtin_amdgcn_fence(__ATOMIC_ACQUIRE, "agent");
            xb_add(&bar[XB_XGEN(b.x)], 1u);
            asm volatile("s_waitcnt vmcnt(0)" ::: "memory");
        } else {
            XB_SPIN(xb_ld(&bar[XB_XGEN(b.x)]) == gen, bar);
            __builtin_amdgcn_fence(__ATOMIC_ACQUIRE, "agent");
            asm volatile("s_waitcnt vmcnt(0)" ::: "memory");
        }
    }
    __syncthreads();
}

__global__ void __launch_bounds__(512) fwd_kernel(Args args) {
    extern __shared__ __attribute__((aligned(16))) unsigned char shm[];
    cg::grid_group grid = cg::this_grid();
    Frame F; F.in = args.in; F.X = args.out; F.ws = args.ws; F.lds = (LAS unsigned char*)shm;
    const int wave0 = __builtin_amdgcn_readfirstlane(threadIdx.x >> 6);
    F.tid = 0; F.lane = 0; F.wave = 0;
    unsigned char* W = F.ws + WS_W; unsigned char* R = F.ws + WS_R;
    const u16* H = (const u16*)(F.ws + WS_H);
    if (threadIdx.x < 4) ((LAS unsigned*)(shm + 131072))[threadIdx.x] = 0u;
    __syncthreads();
    XcdBarrier bar = xcd_barrier_post((unsigned*)(F.ws + WS_BAR), (volatile LAS unsigned*)(shm + 131072));
    int ph = 0; bool last_phase = false;
    const int lo = args.ph_lo, hi = args.ph_hi;
#define PHASE(...) do { if (ph >= lo && ph < hi) { F.lane = lane_id_asm(); F.wave = launder_s(wave0); F.tid = F.wave * 64 + F.lane; const int bid = launder_s(blockIdx.x); (void)bid; __VA_ARGS__; if (ph + 1 < hi && !last_phase) { if (hi < 0) grid.sync(); else xcd_barrier(bar); } } ++ph; } while (0)
    PHASE({ phase_mod(F, 0, bid, gridDim.x); if (gridDim.x <= 192) phase_mod(F, 1, bid, gridDim.x); phase_convert(F, 0, 0, bid, gridDim.x); });
    PHASE(phase_init(F));
#pragma unroll 1
    for (int l = 0; l < 2; ++l) {
#pragma unroll 1
        for (int s = 0; s < 2; ++s) {
            if (s == 1) {
                PHASE({ pg8::Gemm g{H, (const u16*)(W + W_MIN), M, NMIXP, 1024}; pg8::StaticOrder S; S.init(M, NMIXP, gridDim.x, bid); EpiMixIn E{R}; REPS(4) pg8::gemm_phase(F.lds, g, S, E, F.tid); });
                PHASE({ REPS(2) phase_attn(F); REPS(6) phase_conv_a2(F, l); });
                PHASE({ pg8::Gemm g{(const u16*)(F.ws + WS_A2), (const u16*)(W + W_B2), M, N2, K2}; pg8::StaticOrder S; S.init(M, N2, gridDim.x, bid);
                        EpiLowRank E{R, (u16*)(F.ws + WS_H), F.in[I_W0] + l * 768, F.in[I_A0] + l * 768}; REPS(5) pg8::gemm_phase(F.lds, g, S, E, F.tid); });
                PHASE({ REPS(1) phase_scan(F, l); if (l == 0 && gridDim.x > 192 && bid >= 192) { phase_mod(F, 1, bid - 192, gridDim.x - 192); phase_convert(F, 1, 1, bid - 192, gridDim.x - 192); } });
                PHASE(phase_fin(F, l));
                PHASE({ pg8::Gemm g{H, (const u16*)(W + W_MOUT), M, 1024, 1024}; pg8::StaticOrder S; S.init(M, 1024, gridDim.x, bid);
                        EpiResid E{F.X, modp(F, l, 0, 1, 2), 1.0f, l * 3, F.in[I_LNG], F.in[I_LNB], F.ws, F.in[I_XP], F.in[I_XS]}; pg8::gemm_phase(F.lds, g, S, E, F.tid); });
                PHASE(phase_ln(F, l, 1, l, 2, false));
            }
            const int sub = s * 2;
            PHASE({ pg8::Gemm g{H, (const u16*)(W + W_FIN) + (size_t)s * NIN * 1024, M, NIN, 1024}; pg8::StaticOrder S; S.init(M, NIN, gridDim.x, bid);
                    EpiSwiglu E{(u16*)(R + R_HID)}; pg8::gemm_phase(F.lds, g, S, E, F.tid); });
            if (DUPK == 3) PHASE({ pg8::Gemm g{H, (const u16*)(W + W_FIN) + (size_t)s * NIN * 1024, M, NIN, 1024}; pg8::StaticOrder S; S.init(M, NIN, gridDim.x, bid);
                    EpiSwiglu E{(u16*)(R + R_HID)}; pg8::gemm_phase(F.lds, g, S, E, F.tid); });
            PHASE({ pg8::Gemm g{(const u16*)(R + R_HID), (const u16*)(W + W_FOUT) + (size_t)s * 1024 * FF, M, 1024, FF}; pg8::StaticOrder S; S.init(M, 1024, gridDim.x, bid);
                    const int pli = s == 1 ? l * 3 + 1 : l * 3 - 1;
                    EpiResid E{F.X, modp(F, l, 0, sub, 2), 0.5f, pli, F.in[I_LNG], F.in[I_LNB], F.ws, F.in[I_XP], F.in[I_XS]}; pg8::gemm_phase(F.lds, g, S, E, F.tid); });
            if (s == 0) PHASE(phase_ln(F, l, 0, l, 1, false));
            else { last_phase = (l == 1); PHASE({ phase_ln(F, l, 2, l == 0 ? 1 : -1, 0, l == 1); if (l == 0) phase_convert(F, 1, gridDim.x > 192 ? 2 : 0, bid, gridDim.x); }); }
        }
    }
#undef PHASE
}

extern "C" void kernel_launch(void* const* d_in, const int* in_sizes, int n_in, void* d_out, int out_size, void* d_ws, size_t ws_size, hipStream_t stream) {
    static int grid = 0;
    if (grid == 0) {
        if (n_in != 25 || out_size != M * D || ws_size < WS_END) { fprintf(stderr, "kernel_launch: unexpected shapes (n_in %d out %d ws %zu need %zu)\n", n_in, out_size, ws_size, (size_t)WS_END); grid = -1; return; }
        int dev = 0, cus = 0, per_cu = 0;
        hipGetDevice(&dev); hipDeviceGetAttribute(&cus, hipDeviceAttributeMultiprocessorCount, dev);
        if (hipFuncSetAttribute((const void*)fwd_kernel, hipFuncAttributeMaxDynamicSharedMemorySize, LDS_BYTES) != hipSuccess) { fprintf(stderr, "kernel_launch: hipFuncSetAttribute failed\n"); grid = -1; return; }
        if (hipOccupancyMaxActiveBlocksPerMultiprocessor(&per_cu, (const void*)fwd_kernel, 512, LDS_BYTES) != hipSuccess || per_cu < 1) { fprintf(stderr, "kernel_launch: occupancy query says %d\n", per_cu); per_cu = 1; }
        (void)hipGetLastError();
        grid = cus;
    }
    if (grid < 0) return;
    if (hipMemsetAsync((char*)d_ws + WS_BAR, 0, XCD_BAR_WORDS * 4, stream) != hipSuccess) { fprintf(stderr, "kernel_launch: memset failed\n"); return; }
    Args a{};
    for (int i = 0; i < 25; ++i) a.in[i] = (const float*)d_in[i];
    a.out = (float*)d_out; a.ws = (unsigned char*)d_ws; a.ph_lo = 0; a.ph_hi = 1000;
    void* params[] = {&a};
    hipError_t e = hipLaunchCooperativeKernel((const void*)fwd_kernel, dim3(grid), dim3(512), params, LDS_BYTES, stream);
    if (e != hipSuccess) fprintf(stderr, "cooperative launch failed: %s (grid %d)\n", hipGetErrorString(e), grid);
}
```

```cpp
#include <hip/hip_runtime.h>
#include <hip/hip_cooperative_groups.h>
#include <cstdio>
namespace cg = cooperative_groups;

#define LAS __attribute__((address_space(3)))
typedef unsigned short u16;
typedef short bf16x8 __attribute__((ext_vector_type(8)));
typedef short s16x4 __attribute__((ext_vector_type(4)));
typedef float f32x4 __attribute__((ext_vector_type(4)));
typedef float f32x2 __attribute__((ext_vector_type(2)));
typedef unsigned u32x4 __attribute__((ext_vector_type(4)));
typedef unsigned u32x2 __attribute__((ext_vector_type(2)));

constexpr int D = 1024, M = 32768, FF = 2816, NIN = 5632, NMIXP = 3584, N2 = 2048, K2 = 384;
constexpr int MPROMPT = 16384;
constexpr float ALPHA = 1.4142135623730951f;
constexpr float LN_EPS = 1e-5f, GN_EPS = 64e-5f;

constexpr size_t WS_MOD = 0;
constexpr size_t WS_W = 524288;
constexpr size_t W_FIN = 0, W_FOUT = W_FIN + 23068672, W_MIN = W_FOUT + 11534336, W_MOUT = W_MIN + 7340032, W_B2 = W_MOUT + 2097152, W_TOTAL = W_B2 + 1572864;
constexpr size_t WS_H = WS_W + W_TOTAL;
constexpr size_t WS_A2 = WS_H + (size_t)M * 1024 * 2;
constexpr size_t WS_R = WS_A2 + (size_t)M * 384 * 2;
constexpr size_t R_HID = 0;
constexpr size_t R_QKV = 0;
constexpr size_t R_CONV = R_QKV + (size_t)M * 1152 * 2;
constexpr size_t R_ZLAT = R_CONV + (size_t)M * 768 * 2;
constexpr size_t R_ZRKV = R_ZLAT + (size_t)M * 384 * 2;
constexpr size_t R_LD = 0;
constexpr size_t R_AA = R_LD + (size_t)2 * M * 384 * 2;
constexpr size_t R_YS = R_AA + (size_t)2 * M * 384 * 2;
constexpr size_t WS_STATS = WS_R + R_ZRKV + (size_t)M * 1152 * 2;
constexpr size_t WS_INV = WS_STATS + (size_t)M * 2 * 4;
constexpr size_t WS_END = WS_INV + (size_t)M * 6 * 4;
static_assert(R_YS + (size_t)2 * M * 384 * 2 <= R_ZRKV, "alias map");
constexpr int LDS_BYTES = 131072 + 16;
constexpr size_t WS_BAR = 458752;
#ifndef DUPK
#define DUPK 0
#endif
#define REPS(k) _Pragma("unroll 1") for (int rep_ = 0; rep_ < (DUPK == (k) ? 2 : 1); ++rep_)

__device__ __forceinline__ unsigned cvt_pk_bf16(float lo, float hi) { unsigned r; asm volatile("v_cvt_pk_bf16_f32 %0, %1, %2" : "=v"(r) : "v"(lo), "v"(hi)); return r; }
__device__ __forceinline__ float bf2f(u16 b) { return __uint_as_float(((unsigned)b) << 16); }
__device__ __forceinline__ unsigned pk_f16(float lo, float hi) { _Float16 a = (_Float16)lo, b = (_Float16)hi; return (unsigned)__builtin_bit_cast(u16, a) | ((unsigned)__builtin_bit_cast(u16, b) << 16); }
__device__ __forceinline__ float h2f(u16 h) { return (float)__builtin_bit_cast(_Float16, h); }
__device__ __forceinline__ float hlo(unsigned u) { return h2f((u16)(u & 0xffffu)); }
__device__ __forceinline__ float hhi(unsigned u) { return h2f((u16)(u >> 16)); }
__device__ __forceinline__ int row_batch(int m) { return m < MPROMPT ? (m >> 13) : 2 + ((m - MPROMPT) >> 12); }
__device__ __forceinline__ void row_info(int m, int& S, int& t) { if (m < MPROMPT) { S = 8192; t = m & 8191; } else { S = 4096; t = m & 4095; } }
__device__ __forceinline__ float sigmoidf_(float x) { return __builtin_amdgcn_rcpf(1.f + __expf(-x)); }
template <int CTRL> __device__ __forceinline__ float dpp_add(float x) {
    return x + __builtin_bit_cast(float, __builtin_amdgcn_update_dpp(0, __builtin_bit_cast(int, x), CTRL, 0xF, 0xF, true));
}
template <int CTRL, int BANK> __device__ __forceinline__ float dpp_mov(float oldv, float x) {
    return __builtin_bit_cast(float, __builtin_amdgcn_update_dpp(__builtin_bit_cast(int, oldv), __builtin_bit_cast(int, x), CTRL, 0xF, BANK, false));
}
__device__ __forceinline__ float allreduce8(float x) {
    x = dpp_add<0xB1>(x); x = dpp_add<0x4E>(x); x = dpp_add<0x141>(x); return x;
}
__device__ __forceinline__ float allreduce16(float x) {
    x = dpp_add<0xB1>(x);
    x = dpp_add<0x4E>(x);
    x = dpp_add<0x141>(x);
    x = dpp_add<0x140>(x);
    return x;
}

__device__ __forceinline__ int launder_v(int x) { asm volatile("" : "+v"(x)); return x; }
__device__ __forceinline__ int launder_s(int x) { asm volatile("" : "+s"(x)); return x; }
__device__ __forceinline__ int lane_id_asm() { int r; asm volatile("v_mbcnt_lo_u32_b32 %0, -1, 0\n\tv_mbcnt_hi_u32_b32 %0, -1, %0" : "=v"(r)); return r; }
__device__ __forceinline__ float wave_sum(float v) {
    v = allreduce16(v);
    const float r0 = __builtin_bit_cast(float, __builtin_amdgcn_readlane(__builtin_bit_cast(int, v), 0)), r1 = __builtin_bit_cast(float, __builtin_amdgcn_readlane(__builtin_bit_cast(int, v), 16));
    const float r2 = __builtin_bit_cast(float, __builtin_amdgcn_readlane(__builtin_bit_cast(int, v), 32)), r3 = __builtin_bit_cast(float, __builtin_amdgcn_readlane(__builtin_bit_cast(int, v), 48));
    return (r0 + r1) + (r2 + r3);
}
struct Args {
    const float* in[25];
    float* out;
    unsigned char* ws;
    int ph_lo, ph_hi;
};
struct Frame {
    const float* const* in;
    float* X;
    unsigned char* ws;
    LAS unsigned char* lds;
    int tid, lane, wave;
};
enum { I_XP = 0, I_XS, I_CP, I_CS, I_WADA, I_BADA, I_LNG, I_LNB, I_FWIN, I_FWOUT, I_WMIN, I_WMOUT, I_RELB, I_CONVW, I_MU, I_W0, I_WUP, I_A0, I_AUP, I_GUP, I_KK, I_KA, I_RK, I_GNG, I_GNB };

__device__ __forceinline__ const float* modp(const Frame& F, int l, int b, int i, int j) { return (const float*)(F.ws + WS_MOD) + ((size_t)((l * 6 + b) * 9 + i * 3 + j)) * 1024; }

namespace pg8 {
constexpr int BM = 256, BK = 64, HALF = 128, HTB = HALF * BK * 2, STAGE_BYTES = 8 * HTB, NXCD = 8, WGM = 8;
__device__ __forceinline__ int lds_byte(int r, int c) { const int st = (r >> 4) * 2 + (c >> 5), rr = r & 15, cc = c & 31, ob = rr * 64 + cc * 2; return st * 1024 + (ob ^ (((ob >> 9) & 1) << 5)); }
__device__ __forceinline__ void stage_rc(int b, int& R, int& C) { const int st = b / 1024, sb = b % 1024, swz = sb ^ (((sb >> 9) & 1) << 5); R = (st >> 1) * 16 + swz / 64; C = (st & 1) * 32 + (swz % 64) / 2; }
__device__ __forceinline__ int perm32(int rho) { const int n = rho >> 4, i = rho & 15; return 8 * (i >> 2) + 4 * n + (i & 3); }
struct Unit { int pm, pn; };
struct Gemm { const u16* A; const u16* Bt; int M, N, K; };
struct StaticOrder {
    int nM, nN, nwg, G, c;
    __device__ void init(int M_, int N_, int G_, int c_) { nM = M_ / BM; nN = N_ / BM; nwg = nM * nN; G = G_; c = c_; }
    __device__ bool next(int i, Unit& u) const {
        const long L = (long)i * G + c; if (L >= nwg) return false;
        int wgid = (int)L; { const int q = nwg / NXCD, r = nwg % NXCD, xcd = wgid % NXCD, off = wgid / NXCD; wgid = (xcd < r ? xcd * (q + 1) : r * (q + 1) + (xcd - r) * q) + off; }
        const int nig = WGM * nN, gid = wgid / nig, fm = gid * WGM, gsz = (nM - fm) < WGM ? (nM - fm) : WGM;
        u.pm = fm + ((wgid % nig) % gsz); u.pn = (wgid % nig) / gsz; return true;
    }
};
template <class Epi>
__device__ __forceinline__ void gemm_phase(LAS unsigned char* lds, const Gemm g, const StaticOrder& S, const Epi& E, int tid) {
    const int wid = __builtin_amdgcn_readfirstlane(tid >> 6), lane = tid & 63, wr = wid >> 2, wc = wid & 3, fr = lane & 15, fq = lane >> 4;
    const int K = g.K, nt = K / BK;
    unsigned voffA[2], voffB[2];
#pragma unroll
    for (int i = 0; i < 2; ++i) { int R, C; stage_rc(tid * 16 + i * 8192, R, C); const int Rb = Epi::PERM ? ((R & ~31) + perm32(R & 31)) : R;
        voffA[i] = (unsigned)(R * K + C) * 2u; voffB[i] = (unsigned)(Rb * K + C) * 2u; }
    const size_t kstep = (size_t)(BK * 2);
    const size_t hstep = (size_t)HALF * K * 2;
    const size_t tstep = 2 * hstep;
    const unsigned ldsw = (unsigned)wid * 1024u;
    const int aoff = lds_byte(wr * 64 + fr, fq * 8), boff = lds_byte(wc * 32 + fr, fq * 8);
#define PG8_SA(b, h) (((b) * 2 + (h)) * HTB)
#define PG8_SB(b, h) ((4 + (b) * 2 + (h)) * HTB)
#define PG8_STAGE(bufoff, gbase, voff) do { _Pragma("unroll") for (int _i = 0; _i < 2; ++_i) \
        __builtin_amdgcn_global_load_lds((const unsigned*)((const char*)(gbase) + (voff)[_i]), (LAS unsigned*)(lds + (bufoff) + ldsw + _i * 8192), 16, 0, 0); } while (0)
#define PG8_LDA(dst, b, h) do { _Pragma("unroll") for (int m = 0; m < 4; ++m) _Pragma("unroll") for (int k = 0; k < 2; ++k) dst[m][k] = *(const LAS bf16x8*)(lds + PG8_SA(b, h) + aoff + m * 2048 + k * 1024); } while (0)
#define PG8_LDB(dst, b, h) do { _Pragma("unroll") for (int n = 0; n < 2; ++n) _Pragma("unroll") for (int k = 0; k < 2; ++k) dst[n][k] = *(const LAS bf16x8*)(lds + PG8_SB(b, h) + boff + n * 2048 + k * 1024); } while (0)
#define PG8_MMA(ai, bj, At, Bt) do { __builtin_amdgcn_s_setprio(1); _Pragma("unroll") for (int m = 0; m < 4; ++m) _Pragma("unroll") for (int n = 0; n < 2; ++n) _Pragma("unroll") for (int k = 0; k < 2; ++k) \
        acc[ai][bj][m][n] = __builtin_amdgcn_mfma_f32_16x16x32_bf16(Bt[n][k], At[m][k], acc[ai][bj][m][n], 0, 0, 0); __builtin_amdgcn_s_setprio(0); } while (0)
#define PG8_WAIT_V(n) asm volatile("s_waitcnt vmcnt(" #n ")" ::: "memory")
#define PG8_WAIT_L(n) asm volatile("s_waitcnt lgkmcnt(" #n ")" ::: "memory")
#define PG8_BAR __builtin_amdgcn_s_barrier()
#define PG8_SCHED __builtin_amdgcn_sched_barrier(0)
    Unit cur, nxt; int ui = 0;
    if (!S.next(0, cur)) return;
    f32x4 acc[2][2][4][2];
#pragma unroll
    for (int a = 0; a < 2; ++a)
#pragma unroll
        for (int b = 0; b < 2; ++b)
#pragma unroll
            for (int m = 0; m < 4; ++m)
#pragma unroll
                for (int n = 0; n < 2; ++n) acc[a][b][m][n] = (f32x4){0.f, 0.f, 0.f, 0.f};
    bf16x8 At[4][2], B0[2][2], B1[2][2];
    const char* cA = (const char*)g.A + (size_t)cur.pm * tstep; const char* cB = (const char*)g.Bt + (size_t)cur.pn * tstep;
    PG8_STAGE(PG8_SB(0, 0), cB, voffB); PG8_STAGE(PG8_SB(0, 1), cB + hstep, voffB); PG8_STAGE(PG8_SA(0, 0), cA, voffA); PG8_STAGE(PG8_SA(0, 1), cA + hstep, voffA);
    if (wr == 1) PG8_BAR;
    PG8_WAIT_V(2); PG8_BAR;
    PG8_STAGE(PG8_SB(1, 0), cB + kstep, voffB); PG8_STAGE(PG8_SA(1, 0), cA + kstep, voffA); PG8_STAGE(PG8_SB(1, 1), cB + hstep + kstep, voffB);
    PG8_WAIT_V(6); PG8_BAR;
    for (;;) {
        const bool has_next = S.next(ui + 1, nxt);
        const char* nA = has_next ? (const char*)g.A + (size_t)nxt.pm * tstep : cA; const char* nB = has_next ? (const char*)g.Bt + (size_t)nxt.pn * tstep : cB;
#pragma unroll 1
        for (int t = 0; t < nt; t += 2) {
            const bool last = (t == nt - 2);
            const char* a1 = cA + (size_t)(t + 1) * kstep;
            const char* a2 = last ? nA : cA + (size_t)(t + 2) * kstep; const char* b2 = last ? nB : cB + (size_t)(t + 2) * kstep;
            const char* a3 = a2 + kstep; const char* b3 = b2 + kstep;
            PG8_LDB(B0, 0, 0); PG8_LDB(B1, 0, 1); PG8_SCHED; PG8_LDA(At, 0, 0); PG8_STAGE(PG8_SA(1, 1), a1 + hstep, voffA);
            PG8_WAIT_V(8); PG8_WAIT_L(0); PG8_BAR; PG8_MMA(0, 0, At, B0); PG8_MMA(0, 1, At, B1); PG8_BAR; PG8_SCHED;
            PG8_LDA(At, 0, 1); PG8_STAGE(PG8_SB(0, 0), b2, voffB); PG8_STAGE(PG8_SB(0, 1), b2 + hstep, voffB); PG8_STAGE(PG8_SA(0, 0), a2, voffA);
            PG8_WAIT_V(8); PG8_WAIT_L(0); PG8_BAR; PG8_MMA(1, 0, At, B0); PG8_MMA(1, 1, At, B1); PG8_BAR; PG8_SCHED;
            PG8_LDB(B0, 1, 0); PG8_LDB(B1, 1, 1); PG8_SCHED; PG8_LDA(At, 1, 0); PG8_STAGE(PG8_SA(0, 1), a2 + hstep, voffA);
            PG8_WAIT_V(8); PG8_WAIT_L(0); PG8_BAR; PG8_MMA(0, 0, At, B0); PG8_MMA(0, 1, At, B1); PG8_BAR; PG8_SCHED;
            PG8_LDA(At, 1, 1); PG8_STAGE(PG8_SB(1, 0), b3, voffB); PG8_STAGE(PG8_SB(1, 1), b3 + hstep, voffB); PG8_STAGE(PG8_SA(1, 0), a3, voffA);
            PG8_WAIT_V(8); PG8_WAIT_L(0); PG8_BAR; PG8_MMA(1, 0, At, B0); PG8_MMA(1, 1, At, B1); PG8_BAR; PG8_SCHED;
        }
        if (wr == 0) PG8_BAR;
        { const int l2 = lane_id_asm(); E(acc, cur, wr, wc, l2 & 15, l2 >> 4); }
        if (!has_next) break;
#pragma unroll
        for (int a = 0; a < 2; ++a)
#pragma unroll
            for (int b = 0; b < 2; ++b)
#pragma unroll
                for (int m = 0; m < 4; ++m)
#pragma unroll
                    for (int n = 0; n < 2; ++n) acc[a][b][m][n] = (f32x4){0.f, 0.f, 0.f, 0.f};
        cur = nxt; cA = nA; cB = nB; ++ui;
        if (wr == 1) PG8_BAR;
    }
    PG8_WAIT_V(0);
    PG8_BAR;
#undef PG8_SA
#undef PG8_SB
#undef PG8_STAGE
#undef PG8_LDA
#undef PG8_LDB
#undef PG8_MMA
#undef PG8_WAIT_V
#undef PG8_WAIT_L
#undef PG8_BAR
#undef PG8_SCHED
}
}

typedef const f32x4 (&AccRef)[2][2][4][2];

struct EpiSwiglu {
    static constexpr bool PERM = true;
    u16* H;
    __device__ __forceinline__ void operator()(AccRef acc, const pg8::Unit& u, int wr, int wc, int fr, int fq) const {
        const int row0 = u.pm * 256 + wr * 64 + fr, col0 = u.pn * 128 + wc * 32 + 8 * fq;
#pragma unroll
        for (int ai = 0; ai < 2; ++ai)
#pragma unroll
            for (int m = 0; m < 4; ++m) {
                float h[8];
#pragma unroll
                for (int n = 0; n < 2; ++n)
#pragma unroll
                    for (int e = 0; e < 4; ++e) { const float gt = acc[ai][0][m][n][e], up = acc[ai][1][m][n][e]; h[n * 4 + e] = gt * __builtin_amdgcn_rcpf(1.f + __expf(-gt)) * up; }
                u32x4 o = {cvt_pk_bf16(h[0], h[1]), cvt_pk_bf16(h[2], h[3]), cvt_pk_bf16(h[4], h[5]), cvt_pk_bf16(h[6], h[7])};
                __builtin_nontemporal_store(o, (u32x4*)(H + (size_t)(row0 + ai * 128 + m * 16) * FF + col0));
            }
    }
};
struct EpiResid {
    static constexpr bool PERM = false;
    float* X; const float* gate0; float scale;
    int pli; const float* lng; const float* lnb; const unsigned char* wsb;
    const float* xp; const float* xs;
    __device__ __forceinline__ void operator()(AccRef acc, const pg8::Unit& u, int wr, int wc, int fr, int fq) const {
        const int row0 = u.pm * 256 + wr * 64 + fr, col0 = u.pn * 256 + wc * 32 + 4 * fq;
        const int pl = launder_s(pli);
        const float* stats = pl >= 0 ? (const float*)(wsb + WS_STATS) : nullptr; const float* lg = lng + (size_t)(pl < 0 ? 0 : pl) * D; const float* lb = lnb + (size_t)(pl < 0 ? 0 : pl) * D;
        const float* gp = gate0 + (size_t)row_batch(u.pm * 256) * 9 * 1024;
        const float* src = pl >= 0 ? (const float*)X : (u.pm < MPROMPT / 256 ? xp : xs - (size_t)MPROMPT * D);
        float mu[8], rs[8];
#pragma unroll
        for (int i = 0; i < 8; ++i) { mu[i] = 0.f; rs[i] = ALPHA;
            if (stats) { const f32x2 sv = *(const f32x2*)(stats + (size_t)(row0 + (i >> 2) * 128 + (i & 3) * 16) * 2); mu[i] = sv[0]; rs[i] = sv[1]; } }
#pragma unroll
        for (int bj = 0; bj < 2; ++bj)
#pragma unroll
            for (int n = 0; n < 2; ++n) {
                const int cc = col0 + bj * 128 + n * 16;
                f32x4 gv = (*(const f32x4*)(gp + cc) + 1.f) * scale, G = (f32x4){1.f, 1.f, 1.f, 1.f}, Bc = (f32x4){0.f, 0.f, 0.f, 0.f};
                if (stats) { G = *(const f32x4*)(lg + cc) * ALPHA; Bc = *(const f32x4*)(lb + cc) * ALPHA; }
#pragma unroll
                for (int i = 0; i < 8; ++i) {
                    const size_t off = (size_t)(row0 + (i >> 2) * 128 + (i & 3) * 16) * D + cc;
                    float* p = X + off;
                    const f32x4 x = *(const f32x4*)(src + off);
                    *(f32x4*)p = ((x - mu[i]) * rs[i]) * G + Bc + gv * acc[i >> 2][bj][i & 3][n];
                }
            }
    }
};
struct EpiMixIn {
    static constexpr bool PERM = true;
    unsigned char* R;
    __device__ __forceinline__ void operator()(AccRef acc, const pg8::Unit& u, int wr, int wc, int fr, int fq) const {
        const int row0 = u.pm * 256 + wr * 64 + fr;
#pragma unroll
        for (int bj = 0; bj < 2; ++bj) {
            const int cb = u.pn * 256 + bj * 128;
            u16* base; int ld, cc; bool asbf = false;
            if (cb < 1152) { base = (u16*)(R + R_QKV); ld = 1152; cc = cb; asbf = true; }
            else if (cb < 1920) { base = (u16*)(R + R_CONV); ld = 768; cc = cb - 1152; }
            else if (cb < 3072) { base = (u16*)(R + R_ZRKV); ld = 1152; cc = cb - 1920; }
            else if (cb < 3456) { base = (u16*)(R + R_ZLAT); ld = 384; cc = cb - 3072; }
            else continue;
            cc += wc * 32 + 8 * fq;
#pragma unroll
            for (int ai = 0; ai < 2; ++ai)
#pragma unroll
                for (int m = 0; m < 4; ++m) {
                    const f32x4 a = acc[ai][bj][m][0], b = acc[ai][bj][m][1];
                    u32x4 o;
                    if (asbf) o = (u32x4){cvt_pk_bf16(a[0], a[1]), cvt_pk_bf16(a[2], a[3]), cvt_pk_bf16(b[0], b[1]), cvt_pk_bf16(b[2], b[3])};
                    else o = (u32x4){pk_f16(a[0], a[1]), pk_f16(a[2], a[3]), pk_f16(b[0], b[1]), pk_f16(b[2], b[3])};
                    __builtin_nontemporal_store(o, (u32x4*)(base + (size_t)(row0 + ai * 128 + m * 16) * ld + cc));
                }
        }
    }
};
struct EpiLowRank {
    static constexpr bool PERM = true;
    unsigned char* R; u16* MIX; const float* w0; const float* a0;
    __device__ __forceinline__ void operator()(AccRef acc, const pg8::Unit& u, int wr, int wc, int fr, int fq) const {
        const int row0 = u.pm * 256 + wr * 64 + fr;
#pragma unroll
        for (int bj = 0; bj < 2; ++bj) {
            const int cb = u.pn * 256 + bj * 128;
            if (cb >= 1920) continue;
            const int c8 = cb + wc * 32 + 8 * fq;
            const int kind = cb < 768 ? 0 : (cb < 1536 ? 1 : 2);
            float bias[8];
#pragma unroll
            for (int e = 0; e < 8; ++e) bias[e] = kind == 0 ? w0[c8 + e] : (kind == 1 ? a0[c8 - 768 + e] : 0.f);
#pragma unroll
            for (int ai = 0; ai < 2; ++ai)
#pragma unroll
                for (int m = 0; m < 4; ++m) {
                    const int row = row0 + ai * 128 + m * 16;
                    float v[8];
#pragma unroll
                    for (int e = 0; e < 8; ++e) v[e] = acc[ai][bj][m][e >> 2][e & 3] + bias[e];
                    if (kind == 0) {
#pragma unroll
                        for (int e = 0; e < 8; ++e) { const float sp = __logf(1.f + __expf(-v[e])); v[e] = -__expf(-sp - 0.5f); }
                        const int dir = c8 / 384, c = c8 % 384;
                        *(u32x4*)((u16*)(R + R_LD) + ((size_t)dir * M + row) * 384 + c) = (u32x4){pk_f16(v[0], v[1]), pk_f16(v[2], v[3]), pk_f16(v[4], v[5]), pk_f16(v[6], v[7])};
                    } else if (kind == 1) {
#pragma unroll
                        for (int e = 0; e < 8; ++e) v[e] = sigmoidf_(v[e]);
                        const int cc = c8 - 768, dir = cc / 384, c = cc % 384;
                        *(u32x4*)((u16*)(R + R_AA) + ((size_t)dir * M + row) * 384 + c) = (u32x4){pk_f16(v[0], v[1]), pk_f16(v[2], v[3]), pk_f16(v[4], v[5]), pk_f16(v[6], v[7])};
                    } else {
                        *(u32x4*)(MIX + (size_t)row * 1024 + 640 + (c8 - 1536)) = (u32x4){cvt_pk_bf16(v[0], v[1]), cvt_pk_bf16(v[2], v[3]), cvt_pk_bf16(v[4], v[5]), cvt_pk_bf16(v[6], v[7])};
                    }
                }
        }
    }
};

template <int KIND>
__device__ __forceinline__ void convert_wt(const Frame& F, const float* src, int K, int ldsrc, int ncols_valid, u16* dst, int nrows, int& task, int tbase, int tstride) {
    LAS float* tile = (LAS float*)F.lds;
    const int ntn = nrows / 64, ntk = K / 64, ntot = ntn * ntk;
    const int nl = F.tid & 63, kq = F.tid >> 6;
    float cur[8];
    auto tile_c0 = [&](int t, int& j0, int& k0) { const int tt = t - tbase, tn = tt % ntn, tk = tt / ntn; j0 = tn * 64; k0 = tk * 64;
        if (KIND == 1) { const int uu = j0 >> 8, w = j0 & 255; return (w < 128) ? uu * 128 + w : 2816 + uu * 128 + (w - 128); } return j0; };
    if (task < tbase + ntot) { int j0, k0; const int c0 = tile_c0(task, j0, k0);
#pragma unroll
        for (int i = 0; i < 8; ++i) { const int c = c0 + nl; cur[i] = (c < ncols_valid) ? src[(size_t)(k0 + kq * 8 + i) * ldsrc + c] : 0.f; } }
    for (; task < tbase + ntot; task += tstride) {
        int j0, k0; (void)tile_c0(task, j0, k0);
        float nxt[8];
        const int ntask = task + tstride;
        if (ntask < tbase + ntot) { int j1, k1; const int c1 = tile_c0(ntask, j1, k1);
#pragma unroll
            for (int i = 0; i < 8; ++i) { const int c = c1 + nl; nxt[i] = (c < ncols_valid) ? src[(size_t)(k1 + kq * 8 + i) * ldsrc + c] : 0.f; } }
        else {
#pragma unroll
            for (int i = 0; i < 8; ++i) nxt[i] = 0.f; }
#pragma unroll
        for (int i = 0; i < 8; ++i) tile[(kq * 8 + i) * 65 + nl] = cur[i];
        __syncthreads();
        { const int n = F.tid >> 3, kc = (F.tid & 7) * 8; float v[8];
#pragma unroll
          for (int i = 0; i < 8; ++i) v[i] = tile[(kc + i) * 65 + n];
          *(u32x4*)(dst + (size_t)(j0 + n) * K + k0 + kc) = (u32x4){cvt_pk_bf16(v[0], v[1]), cvt_pk_bf16(v[2], v[3]), cvt_pk_bf16(v[4], v[5]), cvt_pk_bf16(v[6], v[7])}; }
        __syncthreads();
#pragma unroll
        for (int i = 0; i < 8; ++i) cur[i] = nxt[i];
    }
}
__device__ __forceinline__ void phase_convert(const Frame& F, int l, int part, int vb, int nb) {
    unsigned char* W = F.ws + WS_W;
    int task = vb, base = 0;
    for (int s = 0; s < 2; ++s) {
        if (part == 0 || (part == 1) == (s == 0)) {
            convert_wt<1>(F, F.in[I_FWIN] + (size_t)(l * 2 + s) * 1024 * NIN, 1024, NIN, NIN, (u16*)(W + W_FIN) + (size_t)s * NIN * 1024, NIN, task, base, nb); base += (NIN / 64) * 16;
            convert_wt<0>(F, F.in[I_FWOUT] + (size_t)(l * 2 + s) * FF * 1024, FF, 1024, 1024, (u16*)(W + W_FOUT) + (size_t)s * 1024 * FF, 1024, task, base, nb); base += 16 * (FF / 64);
        }
    }
    if (part != 2) { convert_wt<0>(F, F.in[I_WMIN] + (size_t)l * 1024 * 3456, 1024, 3456, 3456, (u16*)(W + W_MIN), NMIXP, task, base, nb); base += (NMIXP / 64) * 16; }
    if (part != 1) { convert_wt<0>(F, F.in[I_WMOUT] + (size_t)l * 1024 * 1024, 1024, 1024, 1024, (u16*)(W + W_MOUT), 1024, task, base, nb); base += 16 * 16; }
    if (part != 2) {
        const float* wup = F.in[I_WUP] + (size_t)l * 2 * 64 * 384; const float* aup = F.in[I_AUP] + (size_t)l * 2 * 64 * 384; const float* gup = F.in[I_GUP] + (size_t)l * 128 * 384;
        u16* B2 = (u16*)(W + W_B2);
        for (int i = vb * 512 + F.tid; i < N2 * K2; i += nb * 512) {
            const int n = i / K2, k = i % K2; float v = 0.f;
            if (n < 384) { if (k < 64) v = wup[(0 * 64 + k) * 384 + n]; }
            else if (n < 768) { if (k >= 64 && k < 128) v = wup[(1 * 64 + (k - 64)) * 384 + (n - 384)]; }
            else if (n < 1152) { if (k >= 128 && k < 192) v = aup[(0 * 64 + (k - 128)) * 384 + (n - 768)]; }
            else if (n < 1536) { if (k >= 192 && k < 256) v = aup[(1 * 64 + (k - 192)) * 384 + (n - 1152)]; }
            else if (n < 1920) { if (k >= 256) v = gup[(k - 256) * 384 + (n - 1536)]; }
            B2[i] = (u16)(cvt_pk_bf16(v, 0.f) & 0xffffu);
        }
    }
}
__device__ __forceinline__ void phase_mod(const Frame& F, int l, int vb, int nb) {
    LAS float* red = (LAS float*)F.lds;
    float* MOD = (float*)(F.ws + WS_MOD);
    for (int task = vb; task < 144; task += nb) {
        const int cgp = task, cl = F.tid & 63, col = cgp * 64 + cl, kq = F.tid >> 6;
        float a0 = 0, a1 = 0, a2 = 0, a3 = 0, a4 = 0, a5 = 0;
        const float* w = F.in[I_WADA] + (size_t)l * 1024 * 9216 + col;
        const float* cp = F.in[I_CP]; const float* cs = F.in[I_CS];
#pragma unroll 16
        for (int k = kq * 128; k < kq * 128 + 128; ++k) {
            const float wv = w[(size_t)k * 9216];
            a0 += cp[k] * wv; a1 += cp[1024 + k] * wv; a2 += cs[k] * wv; a3 += cs[1024 + k] * wv; a4 += cs[2048 + k] * wv; a5 += cs[3072 + k] * wv;
        }
        LAS float* rp = red + (kq * 64 + cl) * 6;
        rp[0] = a0; rp[1] = a1; rp[2] = a2; rp[3] = a3; rp[4] = a4; rp[5] = a5;
        __syncthreads();
        if (F.tid < 384) { const int b = F.tid >> 6, cc = F.tid & 63; float s = 0.f;
#pragma unroll
            for (int q = 0; q < 8; ++q) s += red[(q * 64 + cc) * 6 + b];
            MOD[(size_t)(l * 6 + b) * 9216 + cgp * 64 + cc] = s + F.in[I_BADA][l * 9216 + cgp * 64 + cc]; }
        __syncthreads();
    }
}
__device__ __forceinline__ void phase_init(const Frame& F) {
    u16* H = (u16*)(F.ws + WS_H);
    for (int i = blockIdx.x * 512 + F.tid; i < M * 256; i += gridDim.x * 512) {
        const int row = i >> 8, c4 = (i & 255) * 4, b = row_batch(row);
        const float* xin = row < MPROMPT ? F.in[I_XP] + (size_t)row * D : F.in[I_XS] + (size_t)(row - MPROMPT) * D;
        const f32x4 v = *(const f32x4*)(xin + c4);
        const f32x4 sh = *(const f32x4*)(modp(F, 0, b, 0, 0) + c4), sc = *(const f32x4*)(modp(F, 0, b, 0, 1) + c4);
        const f32x4 h = v * (sc + 1.f) + sh;
        *(u32x2*)(H + (size_t)row * D + c4) = (u32x2){cvt_pk_bf16(h[0], h[1]), cvt_pk_bf16(h[2], h[3])};
    }
}
__device__ __forceinline__ void phase_ln(const Frame& F, int l, int i, int nl, int ni, bool write_x) {
    float* ST = (float*)(F.ws + WS_STATS);
    u16* H = (u16*)(F.ws + WS_H);
    const float* g = F.in[I_LNG] + (size_t)(l * 3 + i) * D; const float* bb = F.in[I_LNB] + (size_t)(l * 3 + i) * D;
    const int stride = gridDim.x * 8;
    int row = blockIdx.x * 8 + F.wave;
    f32x4 v[4], vn[4];
    if (row < M) {
#pragma unroll
        for (int j = 0; j < 4; ++j) v[j] = *(const f32x4*)(F.X + (size_t)row * D + j * 256 + F.lane * 4);
    }
#pragma unroll 1
    for (; row < M; row += stride) {
        float* xp = F.X + (size_t)row * D;
        const int nrow = row + stride < M ? row + stride : row;
#pragma unroll
        for (int j = 0; j < 4; ++j) vn[j] = *(const f32x4*)(F.X + (size_t)nrow * D + j * 256 + F.lane * 4);
        float s = 0.f;
#pragma unroll
        for (int j = 0; j < 4; ++j) s += v[j][0] + v[j][1] + v[j][2] + v[j][3];
        const float mu = wave_sum(s) * (1.f / D);
        float q = 0.f;
#pragma unroll
        for (int j = 0; j < 4; ++j) { v[j] = v[j] - mu; q += v[j][0] * v[j][0] + v[j][1] * v[j][1] + v[j][2] * v[j][2] + v[j][3] * v[j][3]; }
        const float rstd = rsqrtf(wave_sum(q) * (1.f / D) + LN_EPS);
        const int b = row_batch(row);
        if (!write_x && F.lane == 0) *(f32x2*)(ST + (size_t)row * 2) = (f32x2){mu, rstd};
#pragma unroll
        for (int j = 0; j < 4; ++j) {
            const int c = j * 256 + F.lane * 4;
            const f32x4 y = v[j] * rstd * *(const f32x4*)(g + c) + *(const f32x4*)(bb + c);
            if (write_x) *(f32x4*)(xp + c) = y;
            if (nl >= 0) {
                const f32x4 sh = *(const f32x4*)(modp(F, nl, b, ni, 0) + c), sc = *(const f32x4*)(modp(F, nl, b, ni, 1) + c);
                const f32x4 h = y * (sc + 1.f) + sh;
                *(u32x2*)(H + (size_t)row * D + c) = (u32x2){cvt_pk_bf16(h[0], h[1]), cvt_pk_bf16(h[2], h[3])};
            }
        }
#pragma unroll
        for (int j = 0; j < 4; ++j) v[j] = vn[j];
    }
}

__device__ __forceinline__ void load8h(const u16* p, bool ok, float* o) {
    u32x4 v = ok ? *(const u32x4*)p : (u32x4){0u, 0u, 0u, 0u};
#pragma unroll
    for (int e = 0; e < 4; ++e) { o[2 * e] = hlo(v[e]); o[2 * e + 1] = hhi(v[e]); }
}

__device__ __forceinline__ void phase_conv_a2(const Frame& F, int l) {
    u16* MIX = (u16*)(F.ws + WS_H); u16* A2 = (u16*)(F.ws + WS_A2);
    const u16* CV = (const u16*)(F.ws + WS_R + R_CONV); const u16* ZL = (const u16*)(F.ws + WS_R + R_ZLAT);
    const float* cw = F.in[I_CONVW] + (size_t)l * 3 * 256; const float* mu = F.in[I_MU] + (size_t)l * 1536 + 1152;
    const int nth = gridDim.x * 512, gt = blockIdx.x * 512 + F.tid;
#pragma unroll 2
    for (int i = gt; i < M * 32; i += nth) {
        const int row = i >> 5, c = (i & 31) * 8; int S, t; row_info(row, S, t);
        const u16* p = CV + (size_t)row * 768 + c;
        float gb[8], u0[8], u1[8], u2[8], a[8], b[8];
        load8h(p, true, gb);
        load8h(p + 256, true, a); load8h(p + 512, true, b);
#pragma unroll
        for (int e = 0; e < 8; ++e) u1[e] = a[e] * b[e];
        load8h(p - 768 + 256, t > 0, a); load8h(p - 768 + 512, t > 0, b);
#pragma unroll
        for (int e = 0; e < 8; ++e) u0[e] = a[e] * b[e];
        load8h(p + 768 + 256, t < S - 1, a); load8h(p + 768 + 512, t < S - 1, b);
#pragma unroll
        for (int e = 0; e < 8; ++e) u2[e] = a[e] * b[e];
        float y[8];
#pragma unroll
        for (int e = 0; e < 8; ++e) y[e] = gb[e] * (cw[c + e] * u0[e] + cw[256 + c + e] * u1[e] + cw[512 + c + e] * u2[e]);
        *(u32x4*)(MIX + (size_t)row * 1024 + 384 + c) = (u32x4){cvt_pk_bf16(y[0], y[1]), cvt_pk_bf16(y[2], y[3]), cvt_pk_bf16(y[4], y[5]), cvt_pk_bf16(y[6], y[7])};
    }
#pragma unroll 2
    for (int i = gt; i < M * 48; i += nth) {
        const int row = i / 48, c = (i % 48) * 8; int S, t; row_info(row, S, t);
        const u16* p = ZL + (size_t)row * 384 + c;
        float z[8], zm[8], zp[8], y[8];
        load8h(p, true, z); load8h(p - 384, t > 0, zm); load8h(p + 384, t < S - 1, zp);
#pragma unroll
        for (int e = 0; e < 8; ++e) { const float zs = z[e] + mu[c + e] * (0.5f * (zm[e] + zp[e]) - z[e]); y[e] = c < 128 ? (1.f - 2.f * __builtin_amdgcn_rcpf(1.f + __expf(2.f * zs))) : (c < 256 ? zs : sigmoidf_(zs)); }
        *(u32x4*)(A2 + (size_t)row * 384 + c) = (u32x4){cvt_pk_bf16(y[0], y[1]), cvt_pk_bf16(y[2], y[3]), cvt_pk_bf16(y[4], y[5]), cvt_pk_bf16(y[6], y[7])};
    }
    {
        const u16* ZR = (const u16*)(F.ws + WS_R + R_ZRKV); float* INV = (float*)(F.ws + WS_INV);
        const float* muk = F.in[I_MU] + (size_t)l * 1536 + 384; const float* kkp = F.in[I_KK] + (size_t)l * 384;
#pragma unroll 2
        for (int i = gt; i < M * 48; i += nth) {
            const int item = i >> 3, sub = i & 7, row = item / 6, head = item % 6, c = head * 64 + sub * 8; int S, t; row_info(row, S, t);
            const u16* p = ZR + (size_t)row * 1152 + 384 + c;
            float z[8], zm[8], zp[8];
            load8h(p, true, z); load8h(p - 1152, t > 0, zm); load8h(p + 1152, t < S - 1, zp);
            float q = 0.f;
#pragma unroll
            for (int e = 0; e < 8; ++e) { const float ks = (z[e] + muk[c + e] * (0.5f * (zm[e] + zp[e]) - z[e])) * kkp[c + e]; q += ks * ks; }
            q = allreduce8(q);
            if (sub == 0) INV[(size_t)row * 6 + head] = rsqrtf(fmaxf(q, 1e-24f));
        }
    }
}

__device__ __forceinline__ void att_group(int gi, int& sh, int& g) { if (gi < 12) { sh = 0; g = gi; } else if (gi < 18) { sh = 2; g = gi - 12; } else { sh = 4; g = gi - 18; } }
__device__ __forceinline__ void phase_attn(const Frame& F) {
    LAS float* biasTab = (LAS float*)F.lds;
    LAS u16* vst = (LAS u16*)(F.lds + 16384) + F.wave * (32 * 72);
    const u16* QKV = (const u16*)(F.ws + WS_R + R_QKV); u16* MIX = (u16*)(F.ws + WS_H);
    const float* relb = F.in[I_RELB];
    for (int i = F.tid; i < 3 * 6 * 129; i += 512) {
        const int br = i / (6 * 129), h = (i / 129) % 6, rel = i % 129 - 64, d = br == 0 ? 1 : (br == 1 ? 4 : 16), x = rel * d, n = x < 0 ? -x : x;
        int bk = n < 8 ? n : 8 + (n >= 15) + (n >= 27) + (n >= 50) + (n >= 91) + (n >= 166) + (n >= 305) + (n >= 559);
        if (x > 0) bk += 16;
        biasTab[(br * 6 + h) * 132 + rel + 64] = relb[bk * 6 + h];
    }
    __syncthreads();
    const int lane = F.lane, qi = lane & 15, gq = lane >> 4;
    const int vb = (gridDim.x & 7) == 0 ? (int)(blockIdx.x & 7) * (int)(gridDim.x >> 3) + (int)(blockIdx.x >> 3) : (int)blockIdx.x;
    for (int item = vb * 8 + F.wave; item < 12288; item += gridDim.x * 8) {
        const int r = item & 15, head = (item >> 4) >> 7, stl = (item >> 4) & 127;
        int m0, S, ib;
        if (stl < 64) { m0 = (stl >> 5) * 8192; S = 8192; ib = stl & 31; } else { const int s2 = stl - 64; m0 = MPROMPT + (s2 >> 4) * 4096; S = 4096; ib = s2 & 15; }
        const int pq0 = r + 256 * ib, pq = pq0 + 16 * qi;
        const u16* qp = QKV + (size_t)(m0 + pq) * 1152 + head * 64 + gq * 8;
        const bf16x8 Q0 = *(const bf16x8*)qp, Q1 = *(const bf16x8*)(qp + 32);
        const char* Kb = (const char*)(QKV + (size_t)m0 * 1152 + 384 + head * 64);
        const char* Vb = (const char*)(QKV + (size_t)m0 * 1152 + 768 + head * 64);
        float m_run = -1e30f, l_part = 0.f;
        f32x4 O[4];
#pragma unroll
        for (int n = 0; n < 4; ++n) O[n] = (f32x4){0.f, 0.f, 0.f, 0.f};
        bf16x8 kn[2][2]; u32x4 vn[4];
        {
            int sh, g; att_group(0, sh, g); const int L = S >> sh, rd = r & ((1 << sh) - 1), kb = (pq0 >> sh) - 64 + 32 * g;
#pragma unroll
            for (int tt = 0; tt < 2; ++tt) { int ik = kb + 16 * tt + qi; ik = ik < 0 ? 0 : (ik >= L ? L - 1 : ik); const char* kp = Kb + (unsigned)((rd + (ik << sh)) * 2304 + gq * 16); kn[tt][0] = *(const bf16x8*)kp; kn[tt][1] = *(const bf16x8*)(kp + 64); }
#pragma unroll
            for (int j = 0; j < 4; ++j) { int ik = kb + (lane >> 3) + 8 * j; ik = ik < 0 ? 0 : (ik >= L ? L - 1 : ik); vn[j] = *(const u32x4*)(Vb + (unsigned)((rd + (ik << sh)) * 2304 + (lane & 7) * 16)); }
        }
        for (int gi = 0; gi < 23; ++gi) {
            int sh, g; att_group(gi, sh, g);
            const int L = S >> sh, kb = (pq0 >> sh) - 64 + 32 * g, iq = pq >> sh;
            const int br = sh >> 1;
            bf16x8 kc[2][2]; u32x4 vc[4];
#pragma unroll
            for (int tt = 0; tt < 2; ++tt) { kc[tt][0] = kn[tt][0]; kc[tt][1] = kn[tt][1]; }
#pragma unroll
            for (int j = 0; j < 4; ++j) vc[j] = vn[j];
            {
                int sh2, g2; att_group(gi < 22 ? gi + 1 : gi, sh2, g2); const int L2 = S >> sh2, rd2 = r & ((1 << sh2) - 1), kb2 = (pq0 >> sh2) - 64 + 32 * g2;
#pragma unroll
                for (int tt = 0; tt < 2; ++tt) { int ik = kb2 + 16 * tt + qi; ik = ik < 0 ? 0 : (ik >= L2 ? L2 - 1 : ik); const char* kp = Kb + (unsigned)((rd2 + (ik << sh2)) * 2304 + gq * 16); kn[tt][0] = *(const bf16x8*)kp; kn[tt][1] = *(const bf16x8*)(kp + 64); }
#pragma unroll
                for (int j = 0; j < 4; ++j) { int ik = kb2 + (lane >> 3) + 8 * j; ik = ik < 0 ? 0 : (ik >= L2 ? L2 - 1 : ik); vn[j] = *(const u32x4*)(Vb + (unsigned)((rd2 + (ik << sh2)) * 2304 + (lane & 7) * 16)); }
            }
#pragma unroll
            for (int j = 0; j < 4; ++j) *(LAS u32x4*)(vst + ((lane >> 3) + 8 * j) * 72 + (lane & 7) * 8) = vc[j];
            float s[8], bv[8];
            const int relb = kb + 4 * gq - iq;
            const LAS float* bt = biasTab + (br * 6 + head) * 132;
#pragma unroll
            for (int j = 0; j < 8; ++j) { int ri = relb + 16 * (j >> 2) + (j & 3) + 64; ri = ri < 0 ? 0 : (ri > 128 ? 128 : ri); bv[j] = bt[ri]; }
#pragma unroll
            for (int j = 0; j < 8; ++j) asm volatile("" : "+v"(bv[j]));
#pragma unroll
            for (int tt = 0; tt < 2; ++tt) {
                f32x4 st = (f32x4){0.f, 0.f, 0.f, 0.f};
                st = __builtin_amdgcn_mfma_f32_16x16x32_bf16(kc[tt][0], Q0, st, 0, 0, 0);
                st = __builtin_amdgcn_mfma_f32_16x16x32_bf16(kc[tt][1], Q1, st, 0, 0, 0);
#pragma unroll
                for (int e = 0; e < 4; ++e) {
                    const int rel = relb + 16 * tt + e, ik = rel + iq;
                    const bool valid = ((unsigned)(rel + 64) <= 128u) && ((unsigned)ik < (unsigned)L);
                    s[tt * 4 + e] = valid ? st[e] * 0.125f + bv[tt * 4 + e] : -INFINITY;
                }
            }
            float gmax = s[0];
#pragma unroll
            for (int e = 1; e < 8; ++e) gmax = fmaxf(gmax, s[e]);
            float alpha = 1.f;
            const bool need = __any(gmax > m_run + 8.0f);
            if (need) {
                gmax = fmaxf(gmax, __shfl_xor(gmax, 16, 64)); gmax = fmaxf(gmax, __shfl_xor(gmax, 32, 64));
                const float mnew = fmaxf(m_run, gmax); alpha = __expf(m_run - mnew); m_run = mnew;
            }
            float p[8], ps = 0.f;
#pragma unroll
            for (int e = 0; e < 8; ++e) { p[e] = __expf(s[e] - m_run); ps += p[e]; }
            l_part = l_part * alpha + ps;
            bf16x8 Pf;
            { const unsigned a = cvt_pk_bf16(p[0], p[1]), b = cvt_pk_bf16(p[2], p[3]), c = cvt_pk_bf16(p[4], p[5]), dd = cvt_pk_bf16(p[6], p[7]); u32x4 t4 = {a, b, c, dd}; Pf = __builtin_bit_cast(bf16x8, t4); }
            if (need) {
#pragma unroll
                for (int n = 0; n < 4; ++n) O[n] = O[n] * alpha;
            }
#pragma unroll
            for (int n = 0; n < 4; ++n) {
                const s16x4 v0 = __builtin_amdgcn_ds_read_tr16_b64_v4i16((LAS s16x4*)(vst + (4 * gq + (qi >> 2)) * 72 + 16 * n + 4 * (qi & 3)));
                const s16x4 v1 = __builtin_amdgcn_ds_read_tr16_b64_v4i16((LAS s16x4*)(vst + (16 + 4 * gq + (qi >> 2)) * 72 + 16 * n + 4 * (qi & 3)));
                const bf16x8 Vf = {v0[0], v0[1], v0[2], v0[3], v1[0], v1[1], v1[2], v1[3]};
                O[n] = __builtin_amdgcn_mfma_f32_16x16x32_bf16(Vf, Pf, O[n], 0, 0, 0);
            }
        }
        float lt = l_part; lt += __shfl_xor(lt, 16, 64); lt += __shfl_xor(lt, 32, 64);
        const float inv = 1.f / lt;
        u16* op = MIX + (size_t)(m0 + pq) * 1024 + head * 64 + 4 * gq;
#pragma unroll
        for (int n = 0; n < 4; ++n) { const f32x4 o = O[n] * inv; *(u32x2*)(op + 16 * n) = (u32x2){cvt_pk_bf16(o[0], o[1]), cvt_pk_bf16(o[2], o[3])}; }
    }
}

constexpr int SC_T = 32, SC_VS = 36, SC_BUF = 43264, SC_YB = 2 * SC_BUF;
struct PrepRegs { unsigned zr[10], zk[10], zv[10], aa[8], ld[8]; float inv[8]; };
__device__ __forceinline__ void prep_load(const Frame& F, int m0, int S, int dir, int head, int chunk, PrepRegs& P) {
    const int pw = F.wave - 4, k = F.lane;
    const u16* ZR = (const u16*)(F.ws + WS_R + R_ZRKV);
    const u16* LD = (const u16*)(F.ws + WS_R + R_LD) + (size_t)dir * M * 384; const u16* AAp = (const u16*)(F.ws + WS_R + R_AA) + (size_t)dir * M * 384;
    const int n0 = chunk * SC_T + pw * 8;
    const int tlo = dir ? (S - 1 - n0 - 7) : n0;
#pragma unroll
    for (int j = 0; j < 10; ++j) {
        int t = tlo - 1 + j; t = t < 0 ? 0 : (t >= S ? S - 1 : t);
        const u16* p = ZR + (size_t)(m0 + t) * 1152 + head * 64 + k;
        P.zr[j] = p[0]; P.zk[j] = p[384]; P.zv[j] = p[768];
    }
#pragma unroll
    for (int u = 0; u < 8; ++u) { const size_t ro = (size_t)(m0 + tlo + u) * 384 + head * 64 + k; P.aa[u] = AAp[ro]; P.ld[u] = LD[ro]; P.inv[u] = ((const float*)(F.ws + WS_INV))[(size_t)(m0 + tlo + u) * 6 + head]; }
}
__device__ __forceinline__ void prep_compute(const Frame& F, int S, int dir, int rq, int chunk, LAS unsigned char* buf, const PrepRegs& P, float mur, float muk, float muv, float kkc, float kac) {
    const int pw = F.wave - 4, k = F.lane;
    const int n0 = chunk * SC_T + pw * 8;
    const int tlo = dir ? (S - 1 - n0 - 7) : n0;
    float zr[10], zk[10], zv[10];
#pragma unroll
    for (int j = 0; j < 10; ++j) { zr[j] = h2f((u16)P.zr[j]); zk[j] = h2f((u16)P.zk[j]); zv[j] = h2f((u16)P.zv[j]); }
    if (tlo - 1 < 0) { zr[0] = 0.f; zk[0] = 0.f; zv[0] = 0.f; }
    if (tlo + 8 >= S) { zr[9] = 0.f; zk[9] = 0.f; zv[9] = 0.f; }
    float ldv[8], pre[8], suf[8];
#pragma unroll
    for (int u = 0; u < 8; ++u) ldv[u] = h2f((u16)P.ld[u]);
    pre[0] = ldv[0]; suf[7] = ldv[7];
#pragma unroll
    for (int u = 1; u < 8; ++u) { pre[u] = pre[u - 1] + ldv[u]; suf[7 - u] = suf[8 - u] + ldv[7 - u]; }
    LAS float* Ab = (LAS float*)buf; LAS float* Bb = Ab + 2048; LAS float* Kb = Ab + 4096; LAS float* Rb = Ab + 6144; LAS float* WBb = Ab + 8192; LAS float* Vb = Ab + 10240;
    float Wc[8];
#pragma unroll
    for (int u = 0; u < 8; ++u) Wc[u] = __expf(dir ? suf[u] : pre[u]);
#pragma unroll
    for (int u = 0; u < 8; ++u) {
        const int sp = pw * 8 + (dir ? 7 - u : u);
        const float rs = zr[u + 1] + mur * (0.5f * (zr[u] + zr[u + 2]) - zr[u + 1]);
        const float ks = zk[u + 1] + muk * (0.5f * (zk[u] + zk[u + 2]) - zk[u + 1]);
        const float vs = zv[u + 1] + muv * (0.5f * (zv[u] + zv[u + 2]) - zv[u + 1]);
        const float kk = ks * kkc * P.inv[u];
        const float a = h2f((u16)P.aa[u]);
        const float Wi = __builtin_amdgcn_rcpf(Wc[u]);
        const float Wp = dir ? (u == 7 ? 1.f : Wc[u < 7 ? u + 1 : 7]) : (u == 0 ? 1.f : Wc[u > 0 ? u - 1 : 0]);
        Ab[sp * 64 + k] = Wp * kk; Bb[sp * 64 + k] = -(kk * a) * Wi; Kb[sp * 64 + k] = ks * (1.f + (a - 1.f) * kac) * Wi; Rb[sp * 64 + k] = rs * Wc[u];
        if (u == (dir ? 0 : 7)) WBb[pw * 64 + k] = Wc[u];
        if ((k >> 4) == rq) Vb[(k & 15) * SC_VS + sp] = vs;
    }
}
__device__ __forceinline__ void scan_flush(const Frame& F, int m0, int S, int dir, int head, int rq, int chunk, LAS float* yb) {
    u16* YS = (u16*)(F.ws + WS_R + R_YS) + (size_t)dir * M * 384;
    const int j = F.tid - 256, s = j >> 3, pr = j & 7, n = chunk * SC_T + s, t = dir ? S - 1 - n : n;
    const float y0 = yb[s * 16 + pr * 2], y1 = yb[s * 16 + pr * 2 + 1];
    *(unsigned*)(YS + (size_t)(m0 + t) * 384 + head * 64 + rq * 16 + pr * 2) = cvt_pk_bf16(y0, y1);
}
__device__ __forceinline__ void scan_item(const Frame& F, int l, int seq, int dir, int head, int rq) {
    int m0, S;
    if (seq < 2) { m0 = seq * 8192; S = 8192; } else { m0 = MPROMPT + (seq - 2) * 4096; S = 4096; }
    const int nch = S / SC_T;
    const bool prep = F.wave >= 4;
    float mur = 0.f, muk = 0.f, muv = 0.f, kkc = 0.f, kac = 0.f;
    if (prep) { const float* mu = F.in[I_MU] + (size_t)l * 1536 + head * 64 + F.lane; mur = mu[0]; muk = mu[384]; muv = mu[768];
        kkc = F.in[I_KK][l * 384 + head * 64 + F.lane]; kac = F.in[I_KA][l * 384 + head * 64 + F.lane]; }
    __syncthreads();
    f32x4 st = (f32x4){0.f, 0.f, 0.f, 0.f};
    const int rl = F.wave * 4 + (F.lane >> 4), ks4 = (F.lane & 15) * 4;
    if (!prep) __builtin_amdgcn_s_setprio(2);
    if (prep) {
        PrepRegs P0, P1;
        prep_load(F, m0, S, dir, head, 0, P0);
#pragma unroll 1
        for (int c = -1; c <= nch; c += 2) {
            if (c >= 1) scan_flush(F, m0, S, dir, head, rq, c - 1, (LAS float*)(F.lds + SC_YB) + ((c - 1) & 1) * 512);
            if (c + 1 < nch) {
                prep_load(F, m0, S, dir, head, (c + 2 < nch) ? c + 2 : c + 1, P1);
                prep_compute(F, S, dir, rq, c + 1, F.lds + ((c + 1) & 1) * SC_BUF, P0, mur, muk, muv, kkc, kac);
            }
            __syncthreads();
            if (c >= 0) scan_flush(F, m0, S, dir, head, rq, c, (LAS float*)(F.lds + SC_YB) + (c & 1) * 512);
            if (c + 2 < nch) {
                prep_load(F, m0, S, dir, head, (c + 3 < nch) ? c + 3 : c + 2, P0);
                prep_compute(F, S, dir, rq, c + 2, F.lds + ((c + 2) & 1) * SC_BUF, P1, mur, muk, muv, kkc, kac);
            }
            __syncthreads();
        }
    } else {
#pragma unroll 1
    for (int c = -1; c <= nch; ++c) {
        if (c >= 0 && c < nch) {
            LAS float* Wb = (LAS float*)(F.lds + (c & 1) * SC_BUF);
            LAS float* yb = (LAS float*)(F.lds + SC_YB) + (c & 1) * 512;
            const int ln = F.lane;
            const bool b0 = ln & 1, b1 = ln & 2, b2 = ln & 4, b3 = ln & 8;
            const int jst = ((ln >> 2) & 1) * 8 + ((ln >> 3) & 1) * 4 + (ln & 3);
            f32x4 al4 = *(LAS f32x4*)(Wb + ks4), be4 = *(LAS f32x4*)(Wb + 2048 + ks4), ka4 = *(LAS f32x4*)(Wb + 4096 + ks4), r4 = *(LAS f32x4*)(Wb + 6144 + ks4);
            f32x4 al4a = *(LAS f32x4*)(Wb + 64 + ks4), be4a = *(LAS f32x4*)(Wb + 2048 + 64 + ks4), ka4a = *(LAS f32x4*)(Wb + 4096 + 64 + ks4), r4a = *(LAS f32x4*)(Wb + 6144 + 64 + ks4);
#pragma unroll 1
            for (int s0 = 0; s0 < SC_T; s0 += 16) {
                float po[16];
                f32x4 vv[4];
#pragma unroll
                for (int q = 0; q < 4; ++q) vv[q] = *(LAS f32x4*)(Wb + 10240 + rl * SC_VS + s0 + 4 * q);
                const f32x4 wb0 = *(LAS f32x4*)(Wb + 8192 + (s0 >> 3) * 64 + ks4), wb1 = *(LAS f32x4*)(Wb + 8192 + ((s0 >> 3) + 1) * 64 + ks4);
#pragma unroll
                for (int j = 0; j < 16; ++j) {
                    const int sn = (s0 + j + 2) & (SC_T - 1);
                    const f32x4 al4n = *(LAS f32x4*)(Wb + sn * 64 + ks4), be4n = *(LAS f32x4*)(Wb + 2048 + sn * 64 + ks4), ka4n = *(LAS f32x4*)(Wb + 4096 + sn * 64 + ks4), r4n = *(LAS f32x4*)(Wb + 6144 + sn * 64 + ks4);
                    const float v = vv[j >> 2][j & 3];
                    f32x2 p = (f32x2){st[0], st[1]} * (f32x2){al4[0], al4[1]}; p = (f32x2){st[2], st[3]} * (f32x2){al4[2], al4[3]} + p;
                    st = ka4 * v + st;
                    const float sa = allreduce16(p[0] + p[1]);
                    st = be4 * sa + st;
                    f32x2 q = (f32x2){st[0], st[1]} * (f32x2){r4[0], r4[1]}; q = (f32x2){st[2], st[3]} * (f32x2){r4[2], r4[3]} + q;
                    po[j] = q[0] + q[1];
                    if (j == 7) st = st * wb0;
                    if (j == 15) st = st * wb1;
                    al4 = al4a; be4 = be4a; ka4 = ka4a; r4 = r4a;
                    al4a = al4n; be4a = be4n; ka4a = ka4n; r4a = r4n;
                }
                float q1[8], q2[4], q3[2];
#pragma unroll
                for (int m = 0; m < 8; ++m) { const float keep = b0 ? po[2 * m + 1] : po[2 * m], give = b0 ? po[2 * m] : po[2 * m + 1]; q1[m] = keep + dpp_mov<0xB1, 0xF>(0.f, give); }
#pragma unroll
                for (int m = 0; m < 4; ++m) { const float keep = b1 ? q1[2 * m + 1] : q1[2 * m], give = b1 ? q1[2 * m] : q1[2 * m + 1]; q2[m] = keep + dpp_mov<0x4E, 0xF>(0.f, give); }
#pragma unroll
                for (int m = 0; m < 2; ++m) { const float keep = b3 ? q2[2 * m + 1] : q2[2 * m], give = b3 ? q2[2 * m] : q2[2 * m + 1]; q3[m] = keep + dpp_mov<0x128, 0xF>(0.f, give); }
                { const float keep = b2 ? q3[1] : q3[0], give = b2 ? q3[0] : q3[1];
                  float rcv = dpp_mov<0x104, 0x5>(0.f, give);
                  rcv = dpp_mov<0x114, 0xA>(rcv, give);
                  yb[(s0 + jst) * 16 + rl] = keep + rcv; }
            }
        }
        __syncthreads();
    }
    }
    __builtin_amdgcn_s_setprio(0);
}
__device__ __forceinline__ void phase_scan(const Frame& F, int l) {
    const int b = blockIdx.x, G = gridDim.x;
    const bool fast = G >= 192;
    const int nit = fast ? (b < 96 ? 1 : (b < 192 ? 2 : 0)) : (b < 288 ? (288 - b + G - 1) / G : 0);
#pragma unroll 1
    for (int it = 0; it < nit; ++it) {
        int seq, dir, head, rq;
        if (fast) {
            if (b < 96) { const int xcd = b & 7, j = b >> 3, c = (j >> 2) * 8 + xcd; rq = j & 3; seq = c / 12; dir = (c / 6) & 1; head = c % 6; }
            else { const int bb = b - 96, xcd = bb & 7, jj = (bb >> 3) * 2 + it, c = (jj >> 2) * 8 + xcd; rq = jj & 3; seq = 2 + c / 12; dir = (c / 6) & 1; head = c % 6; }
        } else {
            const int id = b + it * G, c = id >> 2; rq = id & 3;
            if (c < 24) { seq = c / 12; dir = (c / 6) & 1; head = c % 6; } else { const int c2 = c - 24; seq = 2 + c2 / 12; dir = (c2 / 6) & 1; head = c2 % 6; }
        }
        scan_item(F, l, seq, dir, head, rq);
    }
}
__device__ __forceinline__ void load8b(const u16* p, float* o) {
    const u32x4 v = *(const u32x4*)p;
#pragma unroll
    for (int e = 0; e < 4; ++e) { o[2 * e] = __uint_as_float(v[e] << 16); o[2 * e + 1] = __uint_as_float(v[e] & 0xffff0000u); }
}
__device__ __forceinline__ void phase_fin(const Frame& F, int l) {
    u16* MIX = (u16*)(F.ws + WS_H);
    const u16* YS = (const u16*)(F.ws + WS_R + R_YS); const u16* ZR = (const u16*)(F.ws + WS_R + R_ZRKV);
    const int sub = F.lane & 7;
#pragma unroll 2
    for (int it8 = blockIdx.x * 8 + F.wave; it8 < M * 6 / 8; it8 += gridDim.x * 8) {
        const int item = it8 * 8 + (F.lane >> 3), row = item / 6, head = item % 6, c = head * 64 + sub * 8; int S, t; row_info(row, S, t);
        float y[8], yb[8];
        load8b(YS + (size_t)row * 384 + c, y); load8b(YS + ((size_t)M + row) * 384 + c, yb);
        float s = 0.f;
#pragma unroll
        for (int e = 0; e < 8; ++e) { y[e] += yb[e]; s += y[e]; }
        const float ym = allreduce8(s) * (1.f / 64.f);
        float q = 0.f;
#pragma unroll
        for (int e = 0; e < 8; ++e) { y[e] -= ym; q += y[e] * y[e]; }
        const float rs_ = rsqrtf(allreduce8(q) * (1.f / 64.f) + GN_EPS);
        const u16* p = ZR + (size_t)row * 1152 + c; const float* mu = F.in[I_MU] + (size_t)l * 1536 + c;
        const bool okm = t > 0, okp = t < S - 1;
        float z0[8], zm[8], zp[8], rsv[8], ksv[8], vsv[8];
        load8h(p, true, z0); load8h(p - 1152, okm, zm); load8h(p + 1152, okp, zp);
#pragma unroll
        for (int e = 0; e < 8; ++e) rsv[e] = z0[e] + mu[e] * (0.5f * (zm[e] + zp[e]) - z0[e]);
        load8h(p + 384, true, z0); load8h(p + 384 - 1152, okm, zm); load8h(p + 384 + 1152, okp, zp);
#pragma unroll
        for (int e = 0; e < 8; ++e) ksv[e] = z0[e] + mu[384 + e] * (0.5f * (zm[e] + zp[e]) - z0[e]);
        load8h(p + 768, true, z0); load8h(p + 768 - 1152, okm, zm); load8h(p + 768 + 1152, okp, zp);
#pragma unroll
        for (int e = 0; e < 8; ++e) vsv[e] = z0[e] + mu[768 + e] * (0.5f * (zm[e] + zp[e]) - z0[e]);
        float bs = 0.f;
#pragma unroll
        for (int e = 0; e < 8; ++e) bs += rsv[e] * ksv[e] * F.in[I_RK][l * 384 + c + e];
        const float bon = allreduce8(bs);
        u16* mp = MIX + (size_t)row * 1024 + 640 + c;
        float g[8]; load8b(mp, g);
        float o[8];
#pragma unroll
        for (int e = 0; e < 8; ++e) o[e] = (y[e] * rs_ * F.in[I_GNG][l * 384 + c + e] + F.in[I_GNB][l * 384 + c + e] + bon * vsv[e]) * g[e];
        *(u32x4*)mp = (u32x4){cvt_pk_bf16(o[0], o[1]), cvt_pk_bf16(o[2], o[3]), cvt_pk_bf16(o[4], o[5]), cvt_pk_bf16(o[6], o[7])};
    }
}


#define XB_TMO      128
#define XB_XCNT(j)  (256  + 64 * (j))
#define XB_XSUB(j)  (1280 + 64 * (j))
#define XB_XGEN(j)  (2304 + 64 * (j))
#define XB_TOP      3328
#define XB_TOPGEN   3392
#define XCD_BAR_WORDS 3456
#define XB_SPIN_CAP (1u << 22)
__device__ __forceinline__ unsigned xb_ld(unsigned* p)              { return __hip_atomic_load(p, __ATOMIC_RELAXED, __HIP_MEMORY_SCOPE_AGENT); }
__device__ __forceinline__ unsigned xb_add(unsigned* p, unsigned v) { return __hip_atomic_fetch_add(p, v, __ATOMIC_RELAXED, __HIP_MEMORY_SCOPE_AGENT); }
__device__ __forceinline__ unsigned xb_xcc_id() { return (unsigned)__builtin_amdgcn_s_getreg((3 << 11) | 20) & 0xFu; }
#define XB_SPIN(cond, bar) do { unsigned _sp = 0; while (cond) { __builtin_amdgcn_s_sleep(1); \
    if ((++_sp & 255u) == 0u) { if (xb_ld(&(bar)[XB_TMO])) break; if (_sp > XB_SPIN_CAP) { atomicAdd(&(bar)[XB_TMO], 1u); break; } } } } while (0)
struct XcdBarrier { unsigned* bar; unsigned x; volatile LAS unsigned* st; };
__device__ __forceinline__ XcdBarrier xcd_barrier_post(unsigned* bar, volatile LAS unsigned* st) {
    XcdBarrier b; b.bar = bar; b.x = xb_xcc_id(); b.st = st;
    if (threadIdx.x == 0) (void)xb_add(&bar[XB_XCNT(b.x)], 1u);
    return b;
}
__device__ __forceinline__ void xcd_barrier_complete(unsigned* bar, unsigned x, unsigned& nloc, unsigned& nx) {
    const unsigned G = gridDim.x * gridDim.y * gridDim.z;
    unsigned sum, cnt, mine, sp = 0u;
    for (;;) {
        sum = 0u; cnt = 0u; mine = 0u;
#pragma unroll
        for (unsigned j = 0; j < 16; ++j) { const unsigned c = xb_ld(&bar[XB_XCNT(j)]); sum += c; cnt += (c > 0u) ? 1u : 0u; mine = (j == x) ? c : mine; }
        if (sum == G) break;
        __builtin_amdgcn_s_sleep(1);
        if ((++sp & 255u) == 0u) { if (xb_ld(&bar[XB_TMO])) break; if (sp > XB_SPIN_CAP) { atomicAdd(&bar[XB_TMO], 1u); break; } }
    }
    nloc = mine > 0u ? mine : 1u; nx = cnt > 0u ? cnt : 1u;
}
__device__ __forceinline__ void xcd_barrier(const XcdBarrier& b) {
    asm volatile("s_waitcnt vmcnt(0)" ::: "memory");
    __syncthreads();
    if (threadIdx.x == 0) {
        unsigned* bar = b.bar;
        __builtin_amdgcn_s_waitcnt(0);
        unsigned nloc = b.st[0], nx = b.st[1];
        if (nloc == 0u) { xcd_barrier_complete(bar, b.x, nloc, nx); b.st[0] = nloc; b.st[1] = nx; }
        const unsigned old = xb_add(&bar[XB_XSUB(b.x)], 1u);
        const unsigned gen = old / nloc;
        if (old + 1u == (gen + 1u) * nloc) {
            __builtin_amdgcn_fence(__ATOMIC_RELEASE, "agent");
            asm volatile("s_waitcnt vmcnt(0)" ::: "memory");
            const unsigned og = xb_add(&bar[XB_TOP], 1u);
            const unsigned tg = og / nx;
            if (og + 1u == (tg + 1u) * nx) xb_add(&bar[XB_TOPGEN], 1u);
            else XB_SPIN(xb_ld(&bar[XB_TOPGEN]) == tg, bar);
            __builtin_amdgcn_fence(__ATOMIC_ACQUIRE, "agent");
            xb_add(&bar[XB_XGEN(b.x)], 1u);
            asm volatile("s_waitcnt vmcnt(0)" ::: "memory");
        } else {
            XB_SPIN(xb_ld(&bar[XB_XGEN(b.x)]) == gen, bar);
            __builtin_amdgcn_fence(__ATOMIC_ACQUIRE, "agent");
            asm volatile("s_waitcnt vmcnt(0)" ::: "memory");
        }
    }
    __syncthreads();
}

__global__ void __launch_bounds__(512) fwd_kernel(Args args) {
    extern __shared__ __attribute__((aligned(16))) unsigned char shm[];
    cg::grid_group grid = cg::this_grid();
    Frame F; F.in = args.in; F.X = args.out; F.ws = args.ws; F.lds = (LAS unsigned char*)shm;
    const int wave0 = __builtin_amdgcn_readfirstlane(threadIdx.x >> 6);
    F.tid = 0; F.lane = 0; F.wave = 0;
    unsigned char* W = F.ws + WS_W; unsigned char* R = F.ws + WS_R;
    const u16* H = (const u16*)(F.ws + WS_H);
    if (threadIdx.x < 4) ((LAS unsigned*)(shm + 131072))[threadIdx.x] = 0u;
    __syncthreads();
    XcdBarrier bar = xcd_barrier_post((unsigned*)(F.ws + WS_BAR), (volatile LAS unsigned*)(shm + 131072));
    int ph = 0; bool last_phase = false;
    const int lo = args.ph_lo, hi = args.ph_hi;
#define PHASE(...) do { if (ph >= lo && ph < hi) { F.lane = lane_id_asm(); F.wave = launder_s(wave0); F.tid = F.wave * 64 + F.lane; const int bid = launder_s(blockIdx.x); (void)bid; __VA_ARGS__; if (ph + 1 < hi && !last_phase) { if (hi < 0) grid.sync(); else xcd_barrier(bar); } } ++ph; } while (0)
    PHASE({ phase_mod(F, 0, bid, gridDim.x); if (gridDim.x <= 192) phase_mod(F, 1, bid, gridDim.x); phase_convert(F, 0, 0, bid, gridDim.x); });
    PHASE(phase_init(F));
#pragma unroll 1
    for (int l = 0; l < 2; ++l) {
#pragma unroll 1
        for (int s = 0; s < 2; ++s) {
            if (s == 1) {
                PHASE({ pg8::Gemm g{H, (const u16*)(W + W_MIN), M, NMIXP, 1024}; pg8::StaticOrder S; S.init(M, NMIXP, gridDim.x, bid); EpiMixIn E{R}; REPS(4) pg8::gemm_phase(F.lds, g, S, E, F.tid); });
                PHASE({ REPS(2) phase_attn(F); REPS(6) phase_conv_a2(F, l); });
                PHASE({ pg8::Gemm g{(const u16*)(F.ws + WS_A2), (const u16*)(W + W_B2), M, N2, K2}; pg8::StaticOrder S; S.init(M, N2, gridDim.x, bid);
                        EpiLowRank E{R, (u16*)(F.ws + WS_H), F.in[I_W0] + l * 768, F.in[I_A0] + l * 768}; REPS(5) pg8::gemm_phase(F.lds, g, S, E, F.tid); });
                PHASE({ REPS(1) phase_scan(F, l); if (l == 0 && gridDim.x > 192 && bid >= 192) { phase_mod(F, 1, bid - 192, gridDim.x - 192); phase_convert(F, 1, 1, bid - 192, gridDim.x - 192); } });
                PHASE(phase_fin(F, l));
                PHASE({ pg8::Gemm g{H, (const u16*)(W + W_MOUT), M, 1024, 1024}; pg8::StaticOrder S; S.init(M, 1024, gridDim.x, bid);
                        EpiResid E{F.X, modp(F, l, 0, 1, 2), 1.0f, l * 3, F.in[I_LNG], F.in[I_LNB], F.ws, F.in[I_XP], F.in[I_XS]}; pg8::gemm_phase(F.lds, g, S, E, F.tid); });
                PHASE(phase_ln(F, l, 1, l, 2, false));
            }
            const int sub = s * 2;
            PHASE({ pg8::Gemm g{H, (const u16*)(W + W_FIN) + (size_t)s * NIN * 1024, M, NIN, 1024}; pg8::StaticOrder S; S.init(M, NIN, gridDim.x, bid);
                    EpiSwiglu E{(u16*)(R + R_HID)}; pg8::gemm_phase(F.lds, g, S, E, F.tid); });
            if (DUPK == 3) PHASE({ pg8::Gemm g{H, (const u16*)(W + W_FIN) + (size_t)s * NIN * 1024, M, NIN, 1024}; pg8::StaticOrder S; S.init(M, NIN, gridDim.x, bid);
                    EpiSwiglu E{(u16*)(R + R_HID)}; pg8::gemm_phase(F.lds, g, S, E, F.tid); });
            PHASE({ pg8::Gemm g{(const u16*)(R + R_HID), (const u16*)(W + W_FOUT) + (size_t)s * 1024 * FF, M, 1024, FF}; pg8::StaticOrder S; S.init(M, 1024, gridDim.x, bid);
                    const int pli = s == 1 ? l * 3 + 1 : l * 3 - 1;
                    EpiResid E{F.X, modp(F, l, 0, sub, 2), 0.5f, pli, F.in[I_LNG], F.in[I_LNB], F.ws, F.in[I_XP], F.in[I_XS]}; pg8::gemm_phase(F.lds, g, S, E, F.tid); });
            if (s == 0) PHASE(phase_ln(F, l, 0, l, 1, false));
            else { last_phase = (l == 1); PHASE({ phase_ln(F, l, 2, l == 0 ? 1 : -1, 0, l == 1); if (l == 0) phase_convert(F, 1, gridDim.x > 192 ? 2 : 0, bid, gridDim.x); }); }
        }
    }
#undef PHASE
}

extern "C" void kernel_launch(void* const* d_in, const int* in_sizes, int n_in, void* d_out, int out_size, void* d_ws, size_t ws_size, hipStream_t stream) {
    static int grid = 0;
    if (grid == 0) {
        if (n_in != 25 || out_size != M * D || ws_size < WS_END) { fprintf(stderr, "kernel_launch: unexpected shapes (n_in %d out %d ws %zu need %zu)\n", n_in, out_size, ws_size, (size_t)WS_END); grid = -1; return; }
        int dev = 0, cus = 0, per_cu = 0;
        hipGetDevice(&dev); hipDeviceGetAttribute(&cus, hipDeviceAttributeMultiprocessorCount, dev);
        if (hipFuncSetAttribute((const void*)fwd_kernel, hipFuncAttributeMaxDynamicSharedMemorySize, LDS_BYTES) != hipSuccess) { fprintf(stderr, "kernel_launch: hipFuncSetAttribute failed\n"); grid = -1; return; }
        if (hipOccupancyMaxActiveBlocksPerMultiprocessor(&per_cu, (const void*)fwd_kernel, 512, LDS_BYTES) != hipSuccess || per_cu < 1) { fprintf(stderr, "kernel_launch: occupancy query says %d\n", per_cu); per_cu = 1; }
        (void)hipGetLastError();
        grid = cus;
    }
    if (grid < 0) return;
    if (hipMemsetAsync((char*)d_ws + WS_BAR, 0, XCD_BAR_WORDS * 4, stream) != hipSuccess) { fprintf(stderr, "kernel_launch: memset failed\n"); return; }
    Args a{};
    for (int i = 0; i < 25; ++i) a.in[i] = (const float*)d_in[i];
    a.out = (float*)d_out; a.ws = (unsigned char*)d_ws; a.ph_lo = 0; a.ph_hi = 1000;
    void* params[] = {&a};
    hipError_t e = hipLaunchCooperativeKernel((const void*)fwd_kernel, dim3(grid), dim3(512), params, LDS_BYTES, stream);
    if (e != hipSuccess) fprintf(stderr, "cooperative launch failed: %s (grid %d)\n", hipGetErrorString(e), grid);
}
```

```cpp
#include <hip/hip_runtime.h>
#include <hip/hip_cooperative_groups.h>
#include <cstdio>
namespace cg = cooperative_groups;

#define LAS __attribute__((address_space(3)))
typedef unsigned short u16;
typedef short bf16x8 __attribute__((ext_vector_type(8)));
typedef short s16x4 __attribute__((ext_vector_type(4)));
typedef float f32x4 __attribute__((ext_vector_type(4)));
typedef float f32x2 __attribute__((ext_vector_type(2)));
typedef unsigned u32x4 __attribute__((ext_vector_type(4)));
typedef unsigned u32x2 __attribute__((ext_vector_type(2)));

constexpr int D = 1024, M = 32768, FF = 2816, NIN = 5632, NMIXP = 3584, N2 = 2048, K2 = 384;
constexpr int MPROMPT = 16384;
constexpr float ALPHA = 1.4142135623730951f;
constexpr float LN_EPS = 1e-5f, GN_EPS = 64e-5f;

constexpr size_t WS_MOD = 0;
constexpr size_t WS_W = 524288;
constexpr size_t W_FIN = 0, W_FOUT = W_FIN + 23068672, W_MIN = W_FOUT + 11534336, W_MOUT = W_MIN + 7340032, W_B2 = W_MOUT + 2097152, W_TOTAL = W_B2 + 1572864;
constexpr size_t WS_H = WS_W + W_TOTAL;
constexpr size_t WS_A2 = WS_H + (size_t)M * 1024 * 2;
constexpr size_t WS_R = WS_A2 + (size_t)M * 384 * 2;
constexpr size_t R_HID = 0;
constexpr size_t R_QKV = 0;
constexpr size_t R_CONV = R_QKV + (size_t)M * 1152 * 2;
constexpr size_t R_ZLAT = R_CONV + (size_t)M * 768 * 2;
constexpr size_t R_ZRKV = R_ZLAT + (size_t)M * 384 * 2;
constexpr size_t R_LD = 0;
constexpr size_t R_AA = R_LD + (size_t)2 * M * 384 * 2;
constexpr size_t R_YS = R_AA + (size_t)2 * M * 384 * 2;
constexpr size_t WS_STATS = WS_R + R_ZRKV + (size_t)M * 1152 * 2;
constexpr size_t WS_INV = WS_STATS + (size_t)M * 2 * 4;
constexpr size_t WS_END = WS_INV + (size_t)M * 6 * 4;
static_assert(R_YS + (size_t)2 * M * 384 * 2 <= R_ZRKV, "alias map");
constexpr int LDS_BYTES = 131072 + 16;
constexpr size_t WS_BAR = 458752;
#ifndef DUPK
#define DUPK 0
#endif
#define REPS(k) _Pragma("unroll 1") for (int rep_ = 0; rep_ < (DUPK == (k) ? 2 : 1); ++rep_)

__device__ __forceinline__ unsigned cvt_pk_bf16(float lo, float hi) { unsigned r; asm volatile("v_cvt_pk_bf16_f32 %0, %1, %2" : "=v"(r) : "v"(lo), "v"(hi)); return r; }
__device__ __forceinline__ float bf2f(u16 b) { return __uint_as_float(((unsigned)b) << 16); }
__device__ __forceinline__ unsigned pk_f16(float lo, float hi) { _Float16 a = (_Float16)lo, b = (_Float16)hi; return (unsigned)__builtin_bit_cast(u16, a) | ((unsigned)__builtin_bit_cast(u16, b) << 16); }
__device__ __forceinline__ float h2f(u16 h) { return (float)__builtin_bit_cast(_Float16, h); }
__device__ __forceinline__ float hlo(unsigned u) { return h2f((u16)(u & 0xffffu)); }
__device__ __forceinline__ float hhi(unsigned u) { return h2f((u16)(u >> 16)); }
__device__ __forceinline__ int row_batch(int m) { return m < MPROMPT ? (m >> 13) : 2 + ((m - MPROMPT) >> 12); }
__device__ __forceinline__ void row_info(int m, int& S, int& t) { if (m < MPROMPT) { S = 8192; t = m & 8191; } else { S = 4096; t = m & 4095; } }
__device__ __forceinline__ float sigmoidf_(float x) { return __builtin_amdgcn_rcpf(1.f + __expf(-x)); }
template <int CTRL> __device__ __forceinline__ float dpp_add(float x) {
    return x + __builtin_bit_cast(float, __builtin_amdgcn_update_dpp(0, __builtin_bit_cast(int, x), CTRL, 0xF, 0xF, true));
}
template <int CTRL, int BANK> __device__ __forceinline__ float dpp_mov(float oldv, float x) {
    return __builtin_bit_cast(float, __builtin_amdgcn_update_dpp(__builtin_bit_cast(int, oldv), __builtin_bit_cast(int, x), CTRL, 0xF, BANK, false));
}
__device__ __forceinline__ float allreduce8(float x) {
    x = dpp_add<0xB1>(x); x = dpp_add<0x4E>(x); x = dpp_add<0x141>(x); return x;
}
__device__ __forceinline__ float allreduce16(float x) {
    x = dpp_add<0xB1>(x);
    x = dpp_add<0x4E>(x);
    x = dpp_add<0x141>(x);
    x = dpp_add<0x140>(x);
    return x;
}

__device__ __forceinline__ int launder_v(int x) { asm volatile("" : "+v"(x)); return x; }
__device__ __forceinline__ int launder_s(int x) { asm volatile("" : "+s"(x)); return x; }
__device__ __forceinline__ int lane_id_asm() { int r; asm volatile("v_mbcnt_lo_u32_b32 %0, -1, 0\n\tv_mbcnt_hi_u32_b32 %0, -1, %0" : "=v"(r)); return r; }
__device__ __forceinline__ float wave_sum(float v) {
    v = allreduce16(v);
    const float r0 = __builtin_bit_cast(float, __builtin_amdgcn_readlane(__builtin_bit_cast(int, v), 0)), r1 = __builtin_bit_cast(float, __builtin_amdgcn_readlane(__builtin_bit_cast(int, v), 16));
    const float r2 = __builtin_bit_cast(float, __builtin_amdgcn_readlane(__builtin_bit_cast(int, v), 32)), r3 = __builtin_bit_cast(float, __builtin_amdgcn_readlane(__builtin_bit_cast(int, v), 48));
    return (r0 + r1) + (r2 + r3);
}
struct Args {
    const float* in[25];
    float* out;
    unsigned char* ws;
    int ph_lo, ph_hi;
};
struct Frame {
    const float* const* in;
    float* X;
    unsigned char* ws;
    LAS unsigned char* lds;
    int tid, lane, wave;
};
enum { I_XP = 0, I_XS, I_CP, I_CS, I_WADA, I_BADA, I_LNG, I_LNB, I_FWIN, I_FWOUT, I_WMIN, I_WMOUT, I_RELB, I_CONVW, I_MU, I_W0, I_WUP, I_A0, I_AUP, I_GUP, I_KK, I_KA, I_RK, I_GNG, I_GNB };

__device__ __forceinline__ const float* modp(const Frame& F, int l, int b, int i, int j) { return (const float*)(F.ws + WS_MOD) + ((size_t)((l * 6 + b) * 9 + i * 3 + j)) * 1024; }

namespace pg8 {
constexpr int BM = 256, BK = 64, HALF = 128, HTB = HALF * BK * 2, STAGE_BYTES = 8 * HTB, NXCD = 8, WGM = 8;
__device__ __forceinline__ int lds_byte(int r, int c) { const int st = (r >> 4) * 2 + (c >> 5), rr = r & 15, cc = c & 31, ob = rr * 64 + cc * 2; return st * 1024 + (ob ^ (((ob >> 9) & 1) << 5)); }
__device__ __forceinline__ void stage_rc(int b, int& R, int& C) { const int st = b / 1024, sb = b % 1024, swz = sb ^ (((sb >> 9) & 1) << 5); R = (st >> 1) * 16 + swz / 64; C = (st & 1) * 32 + (swz % 64) / 2; }
__device__ __forceinline__ int perm32(int rho) { const int n = rho >> 4, i = rho & 15; return 8 * (i >> 2) + 4 * n + (i & 3); }
struct Unit { int pm, pn; };
struct Gemm { const u16* A; const u16* Bt; int M, N, K; };
struct StaticOrder {
    int nM, nN, nwg, G, c;
    __device__ void init(int M_, int N_, int G_, int c_) { nM = M_ / BM; nN = N_ / BM; nwg = nM * nN; G = G_; c = c_; }
    __device__ bool next(int i, Unit& u) const {
        const long L = (long)i * G + c; if (L >= nwg) return false;
        int wgid = (int)L; { const int q = nwg / NXCD, r = nwg % NXCD, xcd = wgid % NXCD, off = wgid / NXCD; wgid = (xcd < r ? xcd * (q + 1) : r * (q + 1) + (xcd - r) * q) + off; }
        const int nig = WGM * nN, gid = wgid / nig, fm = gid * WGM, gsz = (nM - fm) < WGM ? (nM - fm) : WGM;
        u.pm = fm + ((wgid % nig) % gsz); u.pn = (wgid % nig) / gsz; return true;
    }
};
template <class Epi>
__device__ __forceinline__ void gemm_phase(LAS unsigned char* lds, const Gemm g, const StaticOrder& S, const Epi& E, int tid) {
    const int wid = __builtin_amdgcn_readfirstlane(tid >> 6), lane = tid & 63, wr = wid >> 2, wc = wid & 3, fr = lane & 15, fq = lane >> 4;
    const int K = g.K, nt = K / BK;
    unsigned voffA[2], voffB[2];
#pragma unroll
    for (int i = 0; i < 2; ++i) { int R, C; stage_rc(tid * 16 + i * 8192, R, C); const int Rb = Epi::PERM ? ((R & ~31) + perm32(R & 31)) : R;
        voffA[i] = (unsigned)(R * K + C) * 2u; voffB[i] = (unsigned)(Rb * K + C) * 2u; }
    const size_t kstep = (size_t)(BK * 2);
    const size_t hstep = (size_t)HALF * K * 2;
    const size_t tstep = 2 * hstep;
    const unsigned ldsw = (unsigned)wid * 1024u;
    const int aoff = lds_byte(wr * 64 + fr, fq * 8), boff = lds_byte(wc * 32 + fr, fq * 8);
#define PG8_SA(b, h) (((b) * 2 + (h)) * HTB)
#define PG8_SB(b, h) ((4 + (b) * 2 + (h)) * HTB)
#define PG8_STAGE(bufoff, gbase, voff) do { _Pragma("unroll") for (int _i = 0; _i < 2; ++_i) \
        __builtin_amdgcn_global_load_lds((const unsigned*)((const char*)(gbase) + (voff)[_i]), (LAS unsigned*)(lds + (bufoff) + ldsw + _i * 8192), 16, 0, 0); } while (0)
#define PG8_LDA(dst, b, h) do { _Pragma("unroll") for (int m = 0; m < 4; ++m) _Pragma("unroll") for (int k = 0; k < 2; ++k) dst[m][k] = *(const LAS bf16x8*)(lds + PG8_SA(b, h) + aoff + m * 2048 + k * 1024); } while (0)
#define PG8_LDB(dst, b, h) do { _Pragma("unroll") for (int n = 0; n < 2; ++n) _Pragma("unroll") for (int k = 0; k < 2; ++k) dst[n][k] = *(const LAS bf16x8*)(lds + PG8_SB(b, h) + boff + n * 2048 + k * 1024); } while (0)
#define PG8_MMA(ai, bj, At, Bt) do { __builtin_amdgcn_s_setprio(1); _Pragma("unroll") for (int m = 0; m < 4; ++m) _Pragma("unroll") for (int n = 0; n < 2; ++n) _Pragma("unroll") for (int k = 0; k < 2; ++k) \
        acc[ai][bj][m][n] = __builtin_amdgcn_mfma_f32_16x16x32_bf16(Bt[n][k], At[m][k], acc[ai][bj][m][n], 0, 0, 0); __builtin_amdgcn_s_setprio(0); } while (0)
#define PG8_WAIT_V(n) asm volatile("s_waitcnt vmcnt(" #n ")" ::: "memory")
#define PG8_WAIT_L(n) asm volatile("s_waitcnt lgkmcnt(" #n ")" ::: "memory")
#define PG8_BAR __builtin_amdgcn_s_barrier()
#define PG8_SCHED __builtin_amdgcn_sched_barrier(0)
    Unit cur, nxt; int ui = 0;
    if (!S.next(0, cur)) return;
    f32x4 acc[2][2][4][2];
#pragma unroll
    for (int a = 0; a < 2; ++a)
#pragma unroll
        for (int b = 0; b < 2; ++b)
#pragma unroll
            for (int m = 0; m < 4; ++m)
#pragma unroll
                for (int n = 0; n < 2; ++n) acc[a][b][m][n] = (f32x4){0.f, 0.f, 0.f, 0.f};
    bf16x8 At[4][2], B0[2][2], B1[2][2];
    const char* cA = (const char*)g.A + (size_t)cur.pm * tstep; const char* cB = (const char*)g.Bt + (size_t)cur.pn * tstep;
    PG8_STAGE(PG8_SB(0, 0), cB, voffB); PG8_STAGE(PG8_SB(0, 1), cB + hstep, voffB); PG8_STAGE(PG8_SA(0, 0), cA, voffA); PG8_STAGE(PG8_SA(0, 1), cA + hstep, voffA);
    if (wr == 1) PG8_BAR;
    PG8_WAIT_V(2); PG8_BAR;
    PG8_STAGE(PG8_SB(1, 0), cB + kstep, voffB); PG8_STAGE(PG8_SA(1, 0), cA + kstep, voffA); PG8_STAGE(PG8_SB(1, 1), cB + hstep + kstep, voffB);
    PG8_WAIT_V(6); PG8_BAR;
    for (;;) {
        const bool has_next = S.next(ui + 1, nxt);
        const char* nA = has_next ? (const char*)g.A + (size_t)nxt.pm * tstep : cA; const char* nB = has_next ? (const char*)g.Bt + (size_t)nxt.pn * tstep : cB;
#pragma unroll 1
        for (int t = 0; t < nt; t += 2) {
            const bool last = (t == nt - 2);
            const char* a1 = cA + (size_t)(t + 1) * kstep;
            const char* a2 = last ? nA : cA + (size_t)(t + 2) * kstep; const char* b2 = last ? nB : cB + (size_t)(t + 2) * kstep;
            const char* a3 = a2 + kstep; const char* b3 = b2 + kstep;
            PG8_LDB(B0, 0, 0); PG8_LDB(B1, 0, 1); PG8_SCHED; PG8_LDA(At, 0, 0); PG8_STAGE(PG8_SA(1, 1), a1 + hstep, voffA);
            PG8_WAIT_V(8); PG8_WAIT_L(0); PG8_BAR; PG8_MMA(0, 0, At, B0); PG8_MMA(0, 1, At, B1); PG8_BAR; PG8_SCHED;
            PG8_LDA(At, 0, 1); PG8_STAGE(PG8_SB(0, 0), b2, voffB); PG8_STAGE(PG8_SB(0, 1), b2 + hstep, voffB); PG8_STAGE(PG8_SA(0, 0), a2, voffA);
            PG8_WAIT_V(8); PG8_WAIT_L(0); PG8_BAR; PG8_MMA(1, 0, At, B0); PG8_MMA(1, 1, At, B1); PG8_BAR; PG8_SCHED;
            PG8_LDB(B0, 1, 0); PG8_LDB(B1, 1, 1); PG8_SCHED; PG8_LDA(At, 1, 0); PG8_STAGE(PG8_SA(0, 1), a2 + hstep, voffA);
            PG8_WAIT_V(8); PG8_WAIT_L(0); PG8_BAR; PG8_MMA(0, 0, At, B0); PG8_MMA(0, 1, At, B1); PG8_BAR; PG8_SCHED;
            PG8_LDA(At, 1, 1); PG8_STAGE(PG8_SB(1, 0), b3, voffB); PG8_STAGE(PG8_SB(1, 1), b3 + hstep, voffB); PG8_STAGE(PG8_SA(1, 0), a3, voffA);
            PG8_WAIT_V(8); PG8_WAIT_L(0); PG8_BAR; PG8_MMA(1, 0, At, B0); PG8_MMA(1, 1, At, B1); PG8_BAR; PG8_SCHED;
        }
        if (wr == 0) PG8_BAR;
        { const int l2 = lane_id_asm(); E(acc, cur, wr, wc, l2 & 15, l2 >> 4); }
        if (!has_next) break;
#pragma unroll
        for (int a = 0; a < 2; ++a)
#pragma unroll
            for (int b = 0; b < 2; ++b)
#pragma unroll
                for (int m = 0; m < 4; ++m)
#pragma unroll
                    for (int n = 0; n < 2; ++n) acc[a][b][m][n] = (f32x4){0.f, 0.f, 0.f, 0.f};
        cur = nxt; cA = nA; cB = nB; ++ui;
        if (wr == 1) PG8_BAR;
    }
    PG8_WAIT_V(0);
    PG8_BAR;
#undef PG8_SA
#undef PG8_SB
#undef PG8_STAGE
#undef PG8_LDA
#undef PG8_LDB
#undef PG8_MMA
#undef PG8_WAIT_V
#undef PG8_WAIT_L
#undef PG8_BAR
#undef PG8_SCHED
}
}

typedef const f32x4 (&AccRef)[2][2][4][2];

struct EpiSwiglu {
    static constexpr bool PERM = true;
    u16* H;
    __device__ __forceinline__ void operator()(AccRef acc, const pg8::Unit& u, int wr, int wc, int fr, int fq) const {
        const int row0 = u.pm * 256 + wr * 64 + fr, col0 = u.pn * 128 + wc * 32 + 8 * fq;
#pragma unroll
        for (int ai = 0; ai < 2; ++ai)
#pragma unroll
            for (int m = 0; m < 4; ++m) {
                float h[8];
#pragma unroll
                for (int n = 0; n < 2; ++n)
#pragma unroll
                    for (int e = 0; e < 4; ++e) { const float gt = acc[ai][0][m][n][e], up = acc[ai][1][m][n][e]; h[n * 4 + e] = gt * __builtin_amdgcn_rcpf(1.f + __expf(-gt)) * up; }
                u32x4 o = {cvt_pk_bf16(h[0], h[1]), cvt_pk_bf16(h[2], h[3]), cvt_pk_bf16(h[4], h[5]), cvt_pk_bf16(h[6], h[7])};
                __builtin_nontemporal_store(o, (u32x4*)(H + (size_t)(row0 + ai * 128 + m * 16) * FF + col0));
            }
    }
};
struct EpiResid {
    static constexpr bool PERM = false;
    float* X; const float* gate0; float scale;
    int pli; const float* lng; const float* lnb; const unsigned char* wsb;
    const float* xp; const float* xs;
    __device__ __forceinline__ void operator()(AccRef acc, const pg8::Unit& u, int wr, int wc, int fr, int fq) const {
        const int row0 = u.pm * 256 + wr * 64 + fr, col0 = u.pn * 256 + wc * 32 + 4 * fq;
        const int pl = launder_s(pli);
        const float* stats = pl >= 0 ? (const float*)(wsb + WS_STATS) : nullptr; const float* lg = lng + (size_t)(pl < 0 ? 0 : pl) * D; const float* lb = lnb + (size_t)(pl < 0 ? 0 : pl) * D;
        const float* gp = gate0 + (size_t)row_batch(u.pm * 256) * 9 * 1024;
        const float* src = pl >= 0 ? (const float*)X : (u.pm < MPROMPT / 256 ? xp : xs - (size_t)MPROMPT * D);
        float mu[8], rs[8];
#pragma unroll
        for (int i = 0; i < 8; ++i) { mu[i] = 0.f; rs[i] = ALPHA;
            if (stats) { const f32x2 sv = *(const f32x2*)(stats + (size_t)(row0 + (i >> 2) * 128 + (i & 3) * 16) * 2); mu[i] = sv[0]; rs[i] = sv[1]; } }
#pragma unroll
        for (int bj = 0; bj < 2; ++bj)
#pragma unroll
            for (int n = 0; n < 2; ++n) {
                const int cc = col0 + bj * 128 + n * 16;
                f32x4 gv = (*(const f32x4*)(gp + cc) + 1.f) * scale, G = (f32x4){1.f, 1.f, 1.f, 1.f}, Bc = (f32x4){0.f, 0.f, 0.f, 0.f};
                if (stats) { G = *(const f32x4*)(lg + cc) * ALPHA; Bc = *(const f32x4*)(lb + cc) * ALPHA; }
#pragma unroll
                for (int i = 0; i < 8; ++i) {
                    const size_t off = (size_t)(row0 + (i >> 2) * 128 + (i & 3) * 16) * D + cc;
                    float* p = X + off;
                    const f32x4 x = *(const f32x4*)(src + off);
                    *(f32x4*)p = ((x - mu[i]) * rs[i]) * G + Bc + gv * acc[i >> 2][bj][i & 3][n];
                }
            }
    }
};
struct EpiMixIn {
    static constexpr bool PERM = true;
    unsigned char* R;
    __device__ __forceinline__ void operator()(AccRef acc, const pg8::Unit& u, int wr, int wc, int fr, int fq) const {
        const int row0 = u.pm * 256 + wr * 64 + fr;
#pragma unroll
        for (int bj = 0; bj < 2; ++bj) {
            const int cb = u.pn * 256 + bj * 128;
            u16* base; int ld, cc; bool asbf = false;
            if (cb < 1152) { base = (u16*)(R + R_QKV); ld = 1152; cc = cb; asbf = true; }
            else if (cb < 1920) { base = (u16*)(R + R_CONV); ld = 768; cc = cb - 1152; }
            else if (cb < 3072) { base = (u16*)(R + R_ZRKV); ld = 1152; cc = cb - 1920; }
            else if (cb < 3456) { base = (u16*)(R + R_ZLAT); ld = 384; cc = cb - 3072; }
            else continue;
            cc += wc * 32 + 8 * fq;
#pragma unroll
            for (int ai = 0; ai < 2; ++ai)
#pragma unroll
                for (int m = 0; m < 4; ++m) {
                    const f32x4 a = acc[ai][bj][m][0], b = acc[ai][bj][m][1];
                    u32x4 o;
                    if (asbf) o = (u32x4){cvt_pk_bf16(a[0], a[1]), cvt_pk_bf16(a[2], a[3]), cvt_pk_bf16(b[0], b[1]), cvt_pk_bf16(b[2], b[3])};
                    else o = (u32x4){pk_f16(a[0], a[1]), pk_f16(a[2], a[3]), pk_f16(b[0], b[1]), pk_f16(b[2], b[3])};
                    __builtin_nontemporal_store(o, (u32x4*)(base + (size_t)(row0 + ai * 128 + m * 16) * ld + cc));
                }
        }
    }
};
struct EpiLowRank {
    static constexpr bool PERM = true;
    unsigned char* R; u16* MIX; const float* w0; const float* a0;
    __device__ __forceinline__ void operator()(AccRef acc, const pg8::Unit& u, int wr, int wc, int fr, int fq) const {
        const int row0 = u.pm * 256 + wr * 64 + fr;
#pragma unroll
        for (int bj = 0; bj < 2; ++bj) {
            const int cb = u.pn * 256 + bj * 128;
            if (cb >= 1920) continue;
            const int c8 = cb + wc * 32 + 8 * fq;
            const int kind = cb < 768 ? 0 : (cb < 1536 ? 1 : 2);
            float bias[8];
#pragma unroll
            for (int e = 0; e < 8; ++e) bias[e] = kind == 0 ? w0[c8 + e] : (kind == 1 ? a0[c8 - 768 + e] : 0.f);
#pragma unroll
            for (int ai = 0; ai < 2; ++ai)
#pragma unroll
                for (int m = 0; m < 4; ++m) {
                    const int row = row0 + ai * 128 + m * 16;
                    float v[8];
#pragma unroll
                    for (int e = 0; e < 8; ++e) v[e] = acc[ai][bj][m][e >> 2][e & 3] + bias[e];
                    if (kind == 0) {
#pragma unroll
                        for (int e = 0; e < 8; ++e) { const float sp = __logf(1.f + __expf(-v[e])); v[e] = -__expf(-sp - 0.5f); }
                        const int dir = c8 / 384, c = c8 % 384;
                        *(u32x4*)((u16*)(R + R_LD) + ((size_t)dir * M + row) * 384 + c) = (u32x4){pk_f16(v[0], v[1]), pk_f16(v[2], v[3]), pk_f16(v[4], v[5]), pk_f16(v[6], v[7])};
                    } else if (kind == 1) {
#pragma unroll
                        for (int e = 0; e < 8; ++e) v[e] = sigmoidf_(v[e]);
                        const int cc = c8 - 768, dir = cc / 384, c = cc % 384;
                        *(u32x4*)((u16*)(R + R_AA) + ((size_t)dir * M + row) * 384 + c) = (u32x4){pk_f16(v[0], v[1]), pk_f16(v[2], v[3]), pk_f16(v[4], v[5]), pk_f16(v[6], v[7])};
                    } else {
                        *(u32x4*)(MIX + (size_t)row * 1024 + 640 + (c8 - 1536)) = (u32x4){cvt_pk_bf16(v[0], v[1]), cvt_pk_bf16(v[2], v[3]), cvt_pk_bf16(v[4], v[5]), cvt_pk_bf16(v[6], v[7])};
                    }
                }
        }
    }
};

template <int KIND>
__device__ __forceinline__ void convert_wt(const Frame& F, const float* src, int K, int ldsrc, int ncols_valid, u16* dst, int nrows, int& task, int tbase, int tstride) {
    LAS float* tile = (LAS float*)F.lds;
    const int ntn = nrows / 64, ntk = K / 64, ntot = ntn * ntk;
    const int nl = F.tid & 63, kq = F.tid >> 6;
    float cur[8];
    auto tile_c0 = [&](int t, int& j0, int& k0) { const int tt = t - tbase, tn = tt % ntn, tk = tt / ntn; j0 = tn * 64; k0 = tk * 64;
        if (KIND == 1) { const int uu = j0 >> 8, w = j0 & 255; return (w < 128) ? uu * 128 + w : 2816 + uu * 128 + (w - 128); } return j0; };
    if (task < tbase + ntot) { int j0, k0; const int c0 = tile_c0(task, j0, k0);
#pragma unroll
        for (int i = 0; i < 8; ++i) { const int c = c0 + nl; cur[i] = (c < ncols_valid) ? src[(size_t)(k0 + kq * 8 + i) * ldsrc + c] : 0.f; } }
    for (; task < tbase + ntot; task += tstride) {
        int j0, k0; (void)tile_c0(task, j0, k0);
        float nxt[8];
        const int ntask = task + tstride;
        if (ntask < tbase + ntot) { int j1, k1; const int c1 = tile_c0(ntask, j1, k1);
#pragma unroll
            for (int i = 0; i < 8; ++i) { const int c = c1 + nl; nxt[i] = (c < ncols_valid) ? src[(size_t)(k1 + kq * 8 + i) * ldsrc + c] : 0.f; } }
        else {
#pragma unroll
            for (int i = 0; i < 8; ++i) nxt[i] = 0.f; }
#pragma unroll
        for (int i = 0; i < 8; ++i) tile[(kq * 8 + i) * 65 + nl] = cur[i];
        __syncthreads();
        { const int n = F.tid >> 3, kc = (F.tid & 7) * 8; float v[8];
#pragma unroll
          for (int i = 0; i < 8; ++i) v[i] = tile[(kc + i) * 65 + n];
          *(u32x4*)(dst + (size_t)(j0 + n) * K + k0 + kc) = (u32x4){cvt_pk_bf16(v[0], v[1]), cvt_pk_bf16(v[2], v[3]), cvt_pk_bf16(v[4], v[5]), cvt_pk_bf16(v[6], v[7])}; }
        __syncthreads();
#pragma unroll
        for (int i = 0; i < 8; ++i) cur[i] = nxt[i];
    }
}
__device__ __forceinline__ void phase_convert(const Frame& F, int l, int part, int vb, int nb) {
    unsigned char* W = F.ws + WS_W;
    int task = vb, base = 0;
    for (int s = 0; s < 2; ++s) {
        if (part == 0 || (part == 1) == (s == 0)) {
            convert_wt<1>(F, F.in[I_FWIN] + (size_t)(l * 2 + s) * 1024 * NIN, 1024, NIN, NIN, (u16*)(W + W_FIN) + (size_t)s * NIN * 1024, NIN, task, base, nb); base += (NIN / 64) * 16;
            convert_wt<0>(F, F.in[I_FWOUT] + (size_t)(l * 2 + s) * FF * 1024, FF, 1024, 1024, (u16*)(W + W_FOUT) + (size_t)s * 1024 * FF, 1024, task, base, nb); base += 16 * (FF / 64);
        }
    }
    if (part != 2) { convert_wt<0>(F, F.in[I_WMIN] + (size_t)l * 1024 * 3456, 1024, 3456, 3456, (u16*)(W + W_MIN), NMIXP, task, base, nb); base += (NMIXP / 64) * 16; }
    if (part != 1) { convert_wt<0>(F, F.in[I_WMOUT] + (size_t)l * 1024 * 1024, 1024, 1024, 1024, (u16*)(W + W_MOUT), 1024, task, base, nb); base += 16 * 16; }
    if (part != 2) {
        const float* wup = F.in[I_WUP] + (size_t)l * 2 * 64 * 384; const float* aup = F.in[I_AUP] + (size_t)l * 2 * 64 * 384; const float* gup = F.in[I_GUP] + (size_t)l * 128 * 384;
        u16* B2 = (u16*)(W + W_B2);
        for (int i = vb * 512 + F.tid; i < N2 * K2; i += nb * 512) {
            const int n = i / K2, k = i % K2; float v = 0.f;
            if (n < 384) { if (k < 64) v = wup[(0 * 64 + k) * 384 + n]; }
            else if (n < 768) { if (k >= 64 && k < 128) v = wup[(1 * 64 + (k - 64)) * 384 + (n - 384)]; }
            else if (n < 1152) { if (k >= 128 && k < 192) v = aup[(0 * 64 + (k - 128)) * 384 + (n - 768)]; }
            else if (n < 1536) { if (k >= 192 && k < 256) v = aup[(1 * 64 + (k - 192)) * 384 + (n - 1152)]; }
            else if (n < 1920) { if (k >= 256) v = gup[(k - 256) * 384 + (n - 1536)]; }
            B2[i] = (u16)(cvt_pk_bf16(v, 0.f) & 0xffffu);
        }
    }
}
__device__ __forceinline__ void phase_mod(const Frame& F, int l, int vb, int nb) {
    LAS float* red = (LAS float*)F.lds;
    float* MOD = (float*)(F.ws + WS_MOD);
    for (int task = vb; task < 144; task += nb) {
        const int cgp = task, cl = F.tid & 63, col = cgp * 64 + cl, kq = F.tid >> 6;
        float a0 = 0, a1 = 0, a2 = 0, a3 = 0, a4 = 0, a5 = 0;
        const float* w = F.in[I_WADA] + (size_t)l * 1024 * 9216 + col;
        const float* cp = F.in[I_CP]; const float* cs = F.in[I_CS];
#pragma unroll 16
        for (int k = kq * 128; k < kq * 128 + 128; ++k) {
            const float wv = w[(size_t)k * 9216];
            a0 += cp[k] * wv; a1 += cp[1024 + k] * wv; a2 += cs[k] * wv; a3 += cs[1024 + k] * wv; a4 += cs[2048 + k] * wv; a5 += cs[3072 + k] * wv;
        }
        LAS float* rp = red + (kq * 64 + cl) * 6;
        rp[0] = a0; rp[1] = a1; rp[2] = a2; rp[3] = a3; rp[4] = a4; rp[5] = a5;
        __syncthreads();
        if (F.tid < 384) { const int b = F.tid >> 6, cc = F.tid & 63; float s = 0.f;
#pragma unroll
            for (int q = 0; q < 8; ++q) s += red[(q * 64 + cc) * 6 + b];
            MOD[(size_t)(l * 6 + b) * 9216 + cgp * 64 + cc] = s + F.in[I_BADA][l * 9216 + cgp * 64 + cc]; }
        __syncthreads();
    }
}
__device__ __forceinline__ void phase_init(const Frame& F) {
    u16* H = (u16*)(F.ws + WS_H);
    for (int i = blockIdx.x * 512 + F.tid; i < M * 256; i += gridDim.x * 512) {
        const int row = i >> 8, c4 = (i & 255) * 4, b = row_batch(row);
        const float* xin = row < MPROMPT ? F.in[I_XP] + (size_t)row * D : F.in[I_XS] + (size_t)(row - MPROMPT) * D;
        const f32x4 v = *(const f32x4*)(xin + c4);
        const f32x4 sh = *(const f32x4*)(modp(F, 0, b, 0, 0) + c4), sc = *(const f32x4*)(modp(F, 0, b, 0, 1) + c4);
        const f32x4 h = v * (sc + 1.f) + sh;
        *(u32x2*)(H + (size_t)row * D + c4) = (u32x2){cvt_pk_bf16(h[0], h[1]), cvt_pk_bf16(h[2], h[3])};
    }
}
__device__ __forceinline__ void phase_ln(const Frame& F, int l, int i, int nl, int ni, bool write_x) {
    float* ST = (float*)(F.ws + WS_STATS);
    u16* H = (u16*)(F.ws + WS_H);
    const float* g = F.in[I_LNG] + (size_t)(l * 3 + i) * D; const float* bb = F.in[I_LNB] + (size_t)(l * 3 + i) * D;
    const int stride = gridDim.x * 8;
    int row = blockIdx.x * 8 + F.wave;
    f32x4 v[4], vn[4];
    if (row < M) {
#pragma unroll
        for (int j = 0; j < 4; ++j) v[j] = *(const f32x4*)(F.X + (size_t)row * D + j * 256 + F.lane * 4);
    }
#pragma unroll 1
    for (; row < M; row += stride) {
        float* xp = F.X + (size_t)row * D;
        const int nrow = row + stride < M ? row + stride : row;
#pragma unroll
        for (int j = 0; j < 4; ++j) vn[j] = *(const f32x4*)(F.X + (size_t)nrow * D + j * 256 + F.lane * 4);
        float s = 0.f;
#pragma unroll
        for (int j = 0; j < 4; ++j) s += v[j][0] + v[j][1] + v[j][2] + v[j][3];
        const float mu = wave_sum(s) * (1.f / D);
        float q = 0.f;
#pragma unroll
        for (int j = 0; j < 4; ++j) { v[j] = v[j] - mu; q += v[j][0] * v[j][0] + v[j][1] * v[j][1] + v[j][2] * v[j][2] + v[j][3] * v[j][3]; }
        const float rstd = rsqrtf(wave_sum(q) * (1.f / D) + LN_EPS);
        const int b = row_batch(row);
        if (!write_x && F.lane == 0) *(f32x2*)(ST + (size_t)row * 2) = (f32x2){mu, rstd};
#pragma unroll
        for (int j = 0; j < 4; ++j) {
            const int c = j * 256 + F.lane * 4;
            const f32x4 y = v[j] * rstd * *(const f32x4*)(g + c) + *(const f32x4*)(bb + c);
            if (write_x) *(f32x4*)(xp + c) = y;
            if (nl >= 0) {
                const f32x4 sh = *(const f32x4*)(modp(F, nl, b, ni, 0) + c), sc = *(const f32x4*)(modp(F, nl, b, ni, 1) + c);
                const f32x4 h = y * (sc + 1.f) + sh;
                *(u32x2*)(H + (size_t)row * D + c) = (u32x2){cvt_pk_bf16(h[0], h[1]), cvt_pk_bf16(h[2], h[3])};
            }
        }
#pragma unroll
        for (int j = 0; j < 4; ++j) v[j] = vn[j];
    }
}

__device__ __forceinline__ void load8h(const u16* p, bool ok, float* o) {
    u32x4 v = ok ? *(const u32x4*)p : (u32x4){0u, 0u, 0u, 0u};
#pragma unroll
    for (int e = 0; e < 4; ++e) { o[2 * e] = hlo(v[e]); o[2 * e + 1] = hhi(v[e]); }
}

__device__ __forceinline__ void phase_conv_a2(const Frame& F, int l) {
    u16* MIX = (u16*)(F.ws + WS_H); u16* A2 = (u16*)(F.ws + WS_A2);
    const u16* CV = (const u16*)(F.ws + WS_R + R_CONV); const u16* ZL = (const u16*)(F.ws + WS_R + R_ZLAT);
    const float* cw = F.in[I_CONVW] + (size_t)l * 3 * 256; const float* mu = F.in[I_MU] + (size_t)l * 1536 + 1152;
    const int nth = gridDim.x * 512, gt = blockIdx.x * 512 + F.tid;
#pragma unroll 2
    for (int i = gt; i < M * 32; i += nth) {
        const int row = i >> 5, c = (i & 31) * 8; int S, t; row_info(row, S, t);
        const u16* p = CV + (size_t)row * 768 + c;
        float gb[8], u0[8], u1[8], u2[8], a[8], b[8];
        load8h(p, true, gb);
        load8h(p + 256, true, a); load8h(p + 512, true, b);
#pragma unroll
        for (int e = 0; e < 8; ++e) u1[e] = a[e] * b[e];
        load8h(p - 768 + 256, t > 0, a); load8h(p - 768 + 512, t > 0, b);
#pragma unroll
        for (int e = 0; e < 8; ++e) u0[e] = a[e] * b[e];
        load8h(p + 768 + 256, t < S - 1, a); load8h(p + 768 + 512, t < S - 1, b);
#pragma unroll
        for (int e = 0; e < 8; ++e) u2[e] = a[e] * b[e];
        float y[8];
#pragma unroll
        for (int e = 0; e < 8; ++e) y[e] = gb[e] * (cw[c + e] * u0[e] + cw[256 + c + e] * u1[e] + cw[512 + c + e] * u2[e]);
        *(u32x4*)(MIX + (size_t)row * 1024 + 384 + c) = (u32x4){cvt_pk_bf16(y[0], y[1]), cvt_pk_bf16(y[2], y[3]), cvt_pk_bf16(y[4], y[5]), cvt_pk_bf16(y[6], y[7])};
    }
#pragma unroll 2
    for (int i = gt; i < M * 48; i += nth) {
        const int row = i / 48, c = (i % 48) * 8; int S, t; row_info(row, S, t);
        const u16* p = ZL + (size_t)row * 384 + c;
        float z[8], zm[8], zp[8], y[8];
        load8h(p, true, z); load8h(p - 384, t > 0, zm); load8h(p + 384, t < S - 1, zp);
#pragma unroll
        for (int e = 0; e < 8; ++e) { const float zs = z[e] + mu[c + e] * (0.5f * (zm[e] + zp[e]) - z[e]); y[e] = c < 128 ? (1.f - 2.f * __builtin_amdgcn_rcpf(1.f + __expf(2.f * zs))) : (c < 256 ? zs : sigmoidf_(zs)); }
        *(u32x4*)(A2 + (size_t)row * 384 + c) = (u32x4){cvt_pk_bf16(y[0], y[1]), cvt_pk_bf16(y[2], y[3]), cvt_pk_bf16(y[4], y[5]), cvt_pk_bf16(y[6], y[7])};
    }
    {
        const u16* ZR = (const u16*)(F.ws + WS_R + R_ZRKV); float* INV = (float*)(F.ws + WS_INV);
        const float* muk = F.in[I_MU] + (size_t)l * 1536 + 384; const float* kkp = F.in[I_KK] + (size_t)l * 384;
#pragma unroll 2
        for (int i = gt; i < M * 48; i += nth) {
            const int item = i >> 3, sub = i & 7, row = item / 6, head = item % 6, c = head * 64 + sub * 8; int S, t; row_info(row, S, t);
            const u16* p = ZR + (size_t)row * 1152 + 384 + c;
            float z[8], zm[8], zp[8];
            load8h(p, true, z); load8h(p - 1152, t > 0, zm); load8h(p + 1152, t < S - 1, zp);
            float q = 0.f;
#pragma unroll
            for (int e = 0; e < 8; ++e) { const float ks = (z[e] + muk[c + e] * (0.5f * (zm[e] + zp[e]) - z[e])) * kkp[c + e]; q += ks * ks; }
            q = allreduce8(q);
            if (sub == 0) INV[(size_t)row * 6 + head] = rsqrtf(fmaxf(q, 1e-24f));
        }
    }
}

__device__ __forceinline__ void att_group(int gi, int& sh, int& g) { if (gi < 12) { sh = 0; g = gi; } else if (gi < 18) { sh = 2; g = gi - 12; } else { sh = 4; g = gi - 18; } }
__device__ __forceinline__ void phase_attn(const Frame& F) {
    LAS float* biasTab = (LAS float*)F.lds;
    LAS u16* vst = (LAS u16*)(F.lds + 16384) + F.wave * (32 * 72);
    const u16* QKV = (const u16*)(F.ws + WS_R + R_QKV); u16* MIX = (u16*)(F.ws + WS_H);
    const float* relb = F.in[I_RELB];
    for (int i = F.tid; i < 3 * 6 * 129; i += 512) {
        const int br = i / (6 * 129), h = (i / 129) % 6, rel = i % 129 - 64, d = br == 0 ? 1 : (br == 1 ? 4 : 16), x = rel * d, n = x < 0 ? -x : x;
        int bk = n < 8 ? n : 8 + (n >= 15) + (n >= 27) + (n >= 50) + (n >= 91) + (n >= 166) + (n >= 305) + (n >= 559);
        if (x > 0) bk += 16;
        biasTab[(br * 6 + h) * 132 + rel + 64] = relb[bk * 6 + h];
    }
    __syncthreads();
    const int lane = F.lane, qi = lane & 15, gq = lane >> 4;
    const int vb = (gridDim.x & 7) == 0 ? (int)(blockIdx.x & 7) * (int)(gridDim.x >> 3) + (int)(blockIdx.x >> 3) : (int)blockIdx.x;
    for (int item = vb * 8 + F.wave; item < 12288; item += gridDim.x * 8) {
        const int r = item & 15, head = (item >> 4) >> 7, stl = (item >> 4) & 127;
        int m0, S, ib;
        if (stl < 64) { m0 = (stl >> 5) * 8192; S = 8192; ib = stl & 31; } else { const int s2 = stl - 64; m0 = MPROMPT + (s2 >> 4) * 4096; S = 4096; ib = s2 & 15; }
        const int pq0 = r + 256 * ib, pq = pq0 + 16 * qi;
        const u16* qp = QKV + (size_t)(m0 + pq) * 1152 + head * 64 + gq * 8;
        const bf16x8 Q0 = *(const bf16x8*)qp, Q1 = *(const bf16x8*)(qp + 32);
        const char* Kb = (const char*)(QKV + (size_t)m0 * 1152 + 384 + head * 64);
        const char* Vb = (const char*)(QKV + (size_t)m0 * 1152 + 768 + head * 64);
        float m_run = -1e30f, l_part = 0.f;
        f32x4 O[4];
#pragma unroll
        for (int n = 0; n < 4; ++n) O[n] = (f32x4){0.f, 0.f, 0.f, 0.f};
        bf16x8 kn[2][2]; u32x4 vn[4];
        {
            int sh, g; att_group(0, sh, g); const int L = S >> sh, rd = r & ((1 << sh) - 1), kb = (pq0 >> sh) - 64 + 32 * g;
#pragma unroll
            for (int tt = 0; tt < 2; ++tt) { int ik = kb + 16 * tt + qi; ik = ik < 0 ? 0 : (ik >= L ? L - 1 : ik); const char* kp = Kb + (unsigned)((rd + (ik << sh)) * 2304 + gq * 16); kn[tt][0] = *(const bf16x8*)kp; kn[tt][1] = *(const bf16x8*)(kp + 64); }
#pragma unroll
            for (int j = 0; j < 4; ++j) { int ik = kb + (lane >> 3) + 8 * j; ik = ik < 0 ? 0 : (ik >= L ? L - 1 : ik); vn[j] = *(const u32x4*)(Vb + (unsigned)((rd + (ik << sh)) * 2304 + (lane & 7) * 16)); }
        }
        for (int gi = 0; gi < 23; ++gi) {
            int sh, g; att_group(gi, sh, g);
            const int L = S >> sh, kb = (pq0 >> sh) - 64 + 32 * g, iq = pq >> sh;
            const int br = sh >> 1;
            bf16x8 kc[2][2]; u32x4 vc[4];
#pragma unroll
            for (int tt = 0; tt < 2; ++tt) { kc[tt][0] = kn[tt][0]; kc[tt][1] = kn[tt][1]; }
#pragma unroll
            for (int j = 0; j < 4; ++j) vc[j] = vn[j];
            {
                int sh2, g2; att_group(gi < 22 ? gi + 1 : gi, sh2, g2); const int L2 = S >> sh2, rd2 = r & ((1 << sh2) - 1), kb2 = (pq0 >> sh2) - 64 + 32 * g2;
#pragma unroll
                for (int tt = 0; tt < 2; ++tt) { int ik = kb2 + 16 * tt + qi; ik = ik < 0 ? 0 : (ik >= L2 ? L2 - 1 : ik); const char* kp = Kb + (unsigned)((rd2 + (ik << sh2)) * 2304 + gq * 16); kn[tt][0] = *(const bf16x8*)kp; kn[tt][1] = *(const bf16x8*)(kp + 64); }
#pragma unroll
                for (int j = 0; j < 4; ++j) { int ik = kb2 + (lane >> 3) + 8 * j; ik = ik < 0 ? 0 : (ik >= L2 ? L2 - 1 : ik); vn[j] = *(const u32x4*)(Vb + (unsigned)((rd2 + (ik << sh2)) * 2304 + (lane & 7) * 16)); }
            }
#pragma unroll
            for (int j = 0; j < 4; ++j) *(LAS u32x4*)(vst + ((lane >> 3) + 8 * j) * 72 + (lane & 7) * 8) = vc[j];
            float s[8], bv[8];
            const int relb = kb + 4 * gq - iq;
            const LAS float* bt = biasTab + (br * 6 + head) * 132;
#pragma unroll
            for (int j = 0; j < 8; ++j) { int ri = relb + 16 * (j >> 2) + (j & 3) + 64; ri = ri < 0 ? 0 : (ri > 128 ? 128 : ri); bv[j] = bt[ri]; }
#pragma unroll
            for (int j = 0; j < 8; ++j) asm volatile("" : "+v"(bv[j]));
#pragma unroll
            for (int tt = 0; tt < 2; ++tt) {
                f32x4 st = (f32x4){0.f, 0.f, 0.f, 0.f};
                __builtin_amdgcn_s_setprio(1);
                st = __builtin_amdgcn_mfma_f32_16x16x32_bf16(kc[tt][0], Q0, st, 0, 0, 0);
                st = __builtin_amdgcn_mfma_f32_16x16x32_bf16(kc[tt][1], Q1, st, 0, 0, 0);
                __builtin_amdgcn_s_setprio(0);
#pragma unroll
                for (int e = 0; e < 4; ++e) {
                    const int rel = relb + 16 * tt + e, ik = rel + iq;
                    const bool valid = ((unsigned)(rel + 64) <= 128u) && ((unsigned)ik < (unsigned)L);
                    s[tt * 4 + e] = valid ? st[e] * 0.125f + bv[tt * 4 + e] : -INFINITY;
                }
            }
            float gmax = s[0];
#pragma unroll
            for (int e = 1; e < 8; ++e) gmax = fmaxf(gmax, s[e]);
            float alpha = 1.f;
            const bool need = __any(gmax > m_run + 8.0f);
            if (need) {
                gmax = fmaxf(gmax, __shfl_xor(gmax, 16, 64)); gmax = fmaxf(gmax, __shfl_xor(gmax, 32, 64));
                const float mnew = fmaxf(m_run, gmax); alpha = __expf(m_run - mnew); m_run = mnew;
            }
            float p[8], ps = 0.f;
#pragma unroll
            for (int e = 0; e < 8; ++e) { p[e] = __expf(s[e] - m_run); ps += p[e]; }
            l_part = l_part * alpha + ps;
            bf16x8 Pf;
            { const unsigned a = cvt_pk_bf16(p[0], p[1]), b = cvt_pk_bf16(p[2], p[3]), c = cvt_pk_bf16(p[4], p[5]), dd = cvt_pk_bf16(p[6], p[7]); u32x4 t4 = {a, b, c, dd}; Pf = __builtin_bit_cast(bf16x8, t4); }
            if (need) {
#pragma unroll
                for (int n = 0; n < 4; ++n) O[n] = O[n] * alpha;
            }
#pragma unroll
            for (int n = 0; n < 4; ++n) {
                const s16x4 v0 = __builtin_amdgcn_ds_read_tr16_b64_v4i16((LAS s16x4*)(vst + (4 * gq + (qi >> 2)) * 72 + 16 * n + 4 * (qi & 3)));
                const s16x4 v1 = __builtin_amdgcn_ds_read_tr16_b64_v4i16((LAS s16x4*)(vst + (16 + 4 * gq + (qi >> 2)) * 72 + 16 * n + 4 * (qi & 3)));
                const bf16x8 Vf = {v0[0], v0[1], v0[2], v0[3], v1[0], v1[1], v1[2], v1[3]};
                __builtin_amdgcn_s_setprio(1);
                O[n] = __builtin_amdgcn_mfma_f32_16x16x32_bf16(Vf, Pf, O[n], 0, 0, 0);
                __builtin_amdgcn_s_setprio(0);
            }
        }
        float lt = l_part; lt += __shfl_xor(lt, 16, 64); lt += __shfl_xor(lt, 32, 64);
        const float inv = 1.f / lt;
        u16* op = MIX + (size_t)(m0 + pq) * 1024 + head * 64 + 4 * gq;
#pragma unroll
        for (int n = 0; n < 4; ++n) { const f32x4 o = O[n] * inv; *(u32x2*)(op + 16 * n) = (u32x2){cvt_pk_bf16(o[0], o[1]), cvt_pk_bf16(o[2], o[3])}; }
    }
}

constexpr int SC_T = 32, SC_VS = 36, SC_BUF = 43264, SC_YB = 2 * SC_BUF;
struct PrepRegs { unsigned zr[10], zk[10], zv[10], aa[8], ld[8]; float inv[8]; };
__device__ __forceinline__ void prep_load(const Frame& F, int m0, int S, int dir, int head, int chunk, PrepRegs& P) {
    const int pw = F.wave - 4, k = F.lane;
    const u16* ZR = (const u16*)(F.ws + WS_R + R_ZRKV);
    const u16* LD = (const u16*)(F.ws + WS_R + R_LD) + (size_t)dir * M * 384; const u16* AAp = (const u16*)(F.ws + WS_R + R_AA) + (size_t)dir * M * 384;
    const int n0 = chunk * SC_T + pw * 8;
    const int tlo = dir ? (S - 1 - n0 - 7) : n0;
#pragma unroll
    for (int j = 0; j < 10; ++j) {
        int t = tlo - 1 + j; t = t < 0 ? 0 : (t >= S ? S - 1 : t);
        const u16* p = ZR + (size_t)(m0 + t) * 1152 + head * 64 + k;
        P.zr[j] = p[0]; P.zk[j] = p[384]; P.zv[j] = p[768];
    }
#pragma unroll
    for (int u = 0; u < 8; ++u) { const size_t ro = (size_t)(m0 + tlo + u) * 384 + head * 64 + k; P.aa[u] = AAp[ro]; P.ld[u] = LD[ro]; P.inv[u] = ((const float*)(F.ws + WS_INV))[(size_t)(m0 + tlo + u) * 6 + head]; }
}
__device__ __forceinline__ void prep_compute(const Frame& F, int S, int dir, int rq, int chunk, LAS unsigned char* buf, const PrepRegs& P, float mur, float muk, float muv, float kkc, float kac) {
    const int pw = F.wave - 4, k = F.lane;
    const int n0 = chunk * SC_T + pw * 8;
    const int tlo = dir ? (S - 1 - n0 - 7) : n0;
    float zr[10], zk[10], zv[10];
#pragma unroll
    for (int j = 0; j < 10; ++j) { zr[j] = h2f((u16)P.zr[j]); zk[j] = h2f((u16)P.zk[j]); zv[j] = h2f((u16)P.zv[j]); }
    if (tlo - 1 < 0) { zr[0] = 0.f; zk[0] = 0.f; zv[0] = 0.f; }
    if (tlo + 8 >= S) { zr[9] = 0.f; zk[9] = 0.f; zv[9] = 0.f; }
    float ldv[8], pre[8], suf[8];
#pragma unroll
    for (int u = 0; u < 8; ++u) ldv[u] = h2f((u16)P.ld[u]);
    pre[0] = ldv[0]; suf[7] = ldv[7];
#pragma unroll
    for (int u = 1; u < 8; ++u) { pre[u] = pre[u - 1] + ldv[u]; suf[7 - u] = suf[8 - u] + ldv[7 - u]; }
    LAS float* Ab = (LAS float*)buf; LAS float* Bb = Ab + 2048; LAS float* Kb = Ab + 4096; LAS float* Rb = Ab + 6144; LAS float* WBb = Ab + 8192; LAS float* Vb = Ab + 10240;
    float Wc[8];
#pragma unroll
    for (int u = 0; u < 8; ++u) Wc[u] = __expf(dir ? suf[u] : pre[u]);
#pragma unroll
    for (int u = 0; u < 8; ++u) {
        const int sp = pw * 8 + (dir ? 7 - u : u);
        const float rs = zr[u + 1] + mur * (0.5f * (zr[u] + zr[u + 2]) - zr[u + 1]);
        const float ks = zk[u + 1] + muk * (0.5f * (zk[u] + zk[u + 2]) - zk[u + 1]);
        const float vs = zv[u + 1] + muv * (0.5f * (zv[u] + zv[u + 2]) - zv[u + 1]);
        const float kk = ks * kkc * P.inv[u];
        const float a = h2f((u16)P.aa[u]);
        const float Wi = __builtin_amdgcn_rcpf(Wc[u]);
        const float Wp = dir ? (u == 7 ? 1.f : Wc[u < 7 ? u + 1 : 7]) : (u == 0 ? 1.f : Wc[u > 0 ? u - 1 : 0]);
        Ab[sp * 64 + k] = Wp * kk; Bb[sp * 64 + k] = -(kk * a) * Wi; Kb[sp * 64 + k] = ks * (1.f + (a - 1.f) * kac) * Wi; Rb[sp * 64 + k] = rs * Wc[u];
        if (u == (dir ? 0 : 7)) WBb[pw * 64 + k] = Wc[u];
        if ((k >> 4) == rq) Vb[(k & 15) * SC_VS + sp] = vs;
    }
}
__device__ __forceinline__ void scan_flush(const Frame& F, int m0, int S, int dir, int head, int rq, int chunk, LAS float* yb) {
    u16* YS = (u16*)(F.ws + WS_R + R_YS) + (size_t)dir * M * 384;
    const int j = F.tid - 256, s = j >> 3, pr = j & 7, n = chunk * SC_T + s, t = dir ? S - 1 - n : n;
    const float y0 = yb[s * 16 + pr * 2], y1 = yb[s * 16 + pr * 2 + 1];
    *(unsigned*)(YS + (size_t)(m0 + t) * 384 + head * 64 + rq * 16 + pr * 2) = cvt_pk_bf16(y0, y1);
}
__device__ __forceinline__ void scan_item(const Frame& F, int l, int seq, int dir, int head, int rq) {
    int m0, S;
    if (seq < 2) { m0 = seq * 8192; S = 8192; } else { m0 = MPROMPT + (seq - 2) * 4096; S = 4096; }
    const int nch = S / SC_T;
    const bool prep = F.wave >= 4;
    float mur = 0.f, muk = 0.f, muv = 0.f, kkc = 0.f, kac = 0.f;
    if (prep) { const float* mu = F.in[I_MU] + (size_t)l * 1536 + head * 64 + F.lane; mur = mu[0]; muk = mu[384]; muv = mu[768];
        kkc = F.in[I_KK][l * 384 + head * 64 + F.lane]; kac = F.in[I_KA][l * 384 + head * 64 + F.lane]; }
    __syncthreads();
    f32x4 st = (f32x4){0.f, 0.f, 0.f, 0.f};
    const int rl = F.wave * 4 + (F.lane >> 4), ks4 = (F.lane & 15) * 4;
    if (!prep) __builtin_amdgcn_s_setprio(2);
    if (prep) {
        PrepRegs P0, P1;
        prep_load(F, m0, S, dir, head, 0, P0);
#pragma unroll 1
        for (int c = -1; c <= nch; c += 2) {
            if (c >= 1) scan_flush(F, m0, S, dir, head, rq, c - 1, (LAS float*)(F.lds + SC_YB) + ((c - 1) & 1) * 512);
            if (c + 1 < nch) {
                prep_load(F, m0, S, dir, head, (c + 2 < nch) ? c + 2 : c + 1, P1);
                prep_compute(F, S, dir, rq, c + 1, F.lds + ((c + 1) & 1) * SC_BUF, P0, mur, muk, muv, kkc, kac);
            }
            __syncthreads();
            if (c >= 0) scan_flush(F, m0, S, dir, head, rq, c, (LAS float*)(F.lds + SC_YB) + (c & 1) * 512);
            if (c + 2 < nch) {
                prep_load(F, m0, S, dir, head, (c + 3 < nch) ? c + 3 : c + 2, P0);
                prep_compute(F, S, dir, rq, c + 2, F.lds + ((c + 2) & 1) * SC_BUF, P1, mur, muk, muv, kkc, kac);
            }
            __syncthreads();
        }
    } else {
#pragma unroll 1
    for (int c = -1; c <= nch; ++c) {
        if (c >= 0 && c < nch) {
            LAS float* Wb = (LAS float*)(F.lds + (c & 1) * SC_BUF);
            LAS float* yb = (LAS float*)(F.lds + SC_YB) + (c & 1) * 512;
            const int ln = F.lane;
            const bool b0 = ln & 1, b1 = ln & 2, b2 = ln & 4, b3 = ln & 8;
            const int jst = ((ln >> 2) & 1) * 8 + ((ln >> 3) & 1) * 4 + (ln & 3);
            f32x4 al4 = *(LAS f32x4*)(Wb + ks4), be4 = *(LAS f32x4*)(Wb + 2048 + ks4), ka4 = *(LAS f32x4*)(Wb + 4096 + ks4), r4 = *(LAS f32x4*)(Wb + 6144 + ks4);
            f32x4 al4a = *(LAS f32x4*)(Wb + 64 + ks4), be4a = *(LAS f32x4*)(Wb + 2048 + 64 + ks4), ka4a = *(LAS f32x4*)(Wb + 4096 + 64 + ks4), r4a = *(LAS f32x4*)(Wb + 6144 + 64 + ks4);
#pragma unroll 1
            for (int s0 = 0; s0 < SC_T; s0 += 16) {
                float po[16];
                f32x4 vv[4];
#pragma unroll
                for (int q = 0; q < 4; ++q) vv[q] = *(LAS f32x4*)(Wb + 10240 + rl * SC_VS + s0 + 4 * q);
                const f32x4 wb0 = *(LAS f32x4*)(Wb + 8192 + (s0 >> 3) * 64 + ks4), wb1 = *(LAS f32x4*)(Wb + 8192 + ((s0 >> 3) + 1) * 64 + ks4);
#pragma unroll
                for (int j = 0; j < 16; ++j) {
                    const int sn = (s0 + j + 2) & (SC_T - 1);
                    const f32x4 al4n = *(LAS f32x4*)(Wb + sn * 64 + ks4), be4n = *(LAS f32x4*)(Wb + 2048 + sn * 64 + ks4), ka4n = *(LAS f32x4*)(Wb + 4096 + sn * 64 + ks4), r4n = *(LAS f32x4*)(Wb + 6144 + sn * 64 + ks4);
                    const float v = vv[j >> 2][j & 3];
                    f32x2 p = (f32x2){st[0], st[1]} * (f32x2){al4[0], al4[1]}; p = (f32x2){st[2], st[3]} * (f32x2){al4[2], al4[3]} + p;
                    st = ka4 * v + st;
                    const float sa = allreduce16(p[0] + p[1]);
                    st = be4 * sa + st;
                    f32x2 q = (f32x2){st[0], st[1]} * (f32x2){r4[0], r4[1]}; q = (f32x2){st[2], st[3]} * (f32x2){r4[2], r4[3]} + q;
                    po[j] = q[0] + q[1];
                    if (j == 7) st = st * wb0;
                    if (j == 15) st = st * wb1;
                    al4 = al4a; be4 = be4a; ka4 = ka4a; r4 = r4a;
                    al4a = al4n; be4a = be4n; ka4a = ka4n; r4a = r4n;
                }
                float q1[8], q2[4], q3[2];
#pragma unroll
                for (int m = 0; m < 8; ++m) { const float keep = b0 ? po[2 * m + 1] : po[2 * m], give = b0 ? po[2 * m] : po[2 * m + 1]; q1[m] = keep + dpp_mov<0xB1, 0xF>(0.f, give); }
#pragma unroll
                for (int m = 0; m < 4; ++m) { const float keep = b1 ? q1[2 * m + 1] : q1[2 * m], give = b1 ? q1[2 * m] : q1[2 * m + 1]; q2[m] = keep + dpp_mov<0x4E, 0xF>(0.f, give); }
#pragma unroll
                for (int m = 0; m < 2; ++m) { const float keep = b3 ? q2[2 * m + 1] : q2[2 * m], give = b3 ? q2[2 * m] : q2[2 * m + 1]; q3[m] = keep + dpp_mov<0x128, 0xF>(0.f, give); }
                { const float keep = b2 ? q3[1] : q3[0], give = b2 ? q3[0] : q3[1];
                  float rcv = dpp_mov<0x104, 0x5>(0.f, give);
                  rcv = dpp_mov<0x114, 0xA>(rcv, give);
                  yb[(s0 + jst) * 16 + rl] = keep + rcv; }
            }
        }
        __syncthreads();
    }
    }
    __builtin_amdgcn_s_setprio(0);
}
__device__ __forceinline__ void phase_scan(const Frame& F, int l) {
    const int b = blockIdx.x, G = gridDim.x;
    const bool fast = G >= 192;
    const int nit = fast ? (b < 96 ? 1 : (b < 192 ? 2 : 0)) : (b < 288 ? (288 - b + G - 1) / G : 0);
#pragma unroll 1
    for (int it = 0; it < nit; ++it) {
        int seq, dir, head, rq;
        if (fast) {
            if (b < 96) { const int xcd = b & 7, j = b >> 3, c = (j >> 2) * 8 + xcd; rq = j & 3; seq = c / 12; dir = (c / 6) & 1; head = c % 6; }
            else { const int bb = b - 96, xcd = bb & 7, jj = (bb >> 3) * 2 + it, c = (jj >> 2) * 8 + xcd; rq = jj & 3; seq = 2 + c / 12; dir = (c / 6) & 1; head = c % 6; }
        } else {
            const int id = b + it * G, c = id >> 2; rq = id & 3;
            if (c < 24) { seq = c / 12; dir = (c / 6) & 1; head = c % 6; } else { const int c2 = c - 24; seq = 2 + c2 / 12; dir = (c2 / 6) & 1; head = c2 % 6; }
        }
        scan_item(F, l, seq, dir, head, rq);
    }
}
__device__ __forceinline__ void load8b(const u16* p, float* o) {
    const u32x4 v = *(const u32x4*)p;
#pragma unroll
    for (int e = 0; e < 4; ++e) { o[2 * e] = __uint_as_float(v[e] << 16); o[2 * e + 1] = __uint_as_float(v[e] & 0xffff0000u); }
}
__device__ __forceinline__ void phase_fin(const Frame& F, int l) {
    u16* MIX = (u16*)(F.ws + WS_H);
    const u16* YS = (const u16*)(F.ws + WS_R + R_YS); const u16* ZR = (const u16*)(F.ws + WS_R + R_ZRKV);
    const int sub = F.lane & 7;
#pragma unroll 2
    for (int it8 = blockIdx.x * 8 + F.wave; it8 < M * 6 / 8; it8 += gridDim.x * 8) {
        const int item = it8 * 8 + (F.lane >> 3), row = item / 6, head = item % 6, c = head * 64 + sub * 8; int S, t; row_info(row, S, t);
        float y[8], yb[8];
        load8b(YS + (size_t)row * 384 + c, y); load8b(YS + ((size_t)M + row) * 384 + c, yb);
        float s = 0.f;
#pragma unroll
        for (int e = 0; e < 8; ++e) { y[e] += yb[e]; s += y[e]; }
        const float ym = allreduce8(s) * (1.f / 64.f);
        float q = 0.f;
#pragma unroll
        for (int e = 0; e < 8; ++e) { y[e] -= ym; q += y[e] * y[e]; }
        const float rs_ = rsqrtf(allreduce8(q) * (1.f / 64.f) + GN_EPS);
        const u16* p = ZR + (size_t)row * 1152 + c; const float* mu = F.in[I_MU] + (size_t)l * 1536 + c;
        const bool okm = t > 0, okp = t < S - 1;
        float z0[8], zm[8], zp[8], rsv[8], ksv[8], vsv[8];
        load8h(p, true, z0); load8h(p - 1152, okm, zm); load8h(p + 1152, okp, zp);
#pragma unroll
        for (int e = 0; e < 8; ++e) rsv[e] = z0[e] + mu[e] * (0.5f * (zm[e] + zp[e]) - z0[e]);
        load8h(p + 384, true, z0); load8h(p + 384 - 1152, okm, zm); load8h(p + 384 + 1152, okp, zp);
#pragma unroll
        for (int e = 0; e < 8; ++e) ksv[e] = z0[e] + mu[384 + e] * (0.5f * (zm[e] + zp[e]) - z0[e]);
        load8h(p + 768, true, z0); load8h(p + 768 - 1152, okm, zm); load8h(p + 768 + 1152, okp, zp);
#pragma unroll
        for (int e = 0; e < 8; ++e) vsv[e] = z0[e] + mu[768 + e] * (0.5f * (zm[e] + zp[e]) - z0[e]);
        float bs = 0.f;
#pragma unroll
        for (int e = 0; e < 8; ++e) bs += rsv[e] * ksv[e] * F.in[I_RK][l * 384 + c + e];
        const float bon = allreduce8(bs);
        u16* mp = MIX + (size_t)row * 1024 + 640 + c;
        float g[8]; load8b(mp, g);
        float o[8];
#pragma unroll
        for (int e = 0; e < 8; ++e) o[e] = (y[e] * rs_ * F.in[I_GNG][l * 384 + c + e] + F.in[I_GNB][l * 384 + c + e] + bon * vsv[e]) * g[e];
        *(u32x4*)mp = (u32x4){cvt_pk_bf16(o[0], o[1]), cvt_pk_bf16(o[2], o[3]), cvt_pk_bf16(o[4], o[5]), cvt_pk_bf16(o[6], o[7])};
    }
}


#define XB_TMO      128
#define XB_XCNT(j)  (256  + 64 * (j))
#define XB_XSUB(j)  (1280 + 64 * (j))
#define XB_XGEN(j)  (2304 + 64 * (j))
#define XB_TOP      3328
#define XB_TOPGEN   3392
#define XCD_BAR_WORDS 3456
#define XB_SPIN_CAP (1u << 22)
__device__ __forceinline__ unsigned xb_ld(unsigned* p)              { return __hip_atomic_load(p, __ATOMIC_RELAXED, __HIP_MEMORY_SCOPE_AGENT); }
__device__ __forceinline__ unsigned xb_add(unsigned* p, unsigned v) { return __hip_atomic_fetch_add(p, v, __ATOMIC_RELAXED, __HIP_MEMORY_SCOPE_AGENT); }
__device__ __forceinline__ unsigned xb_xcc_id() { return (unsigned)__builtin_amdgcn_s_getreg((3 << 11) | 20) & 0xFu; }
#define XB_SPIN(cond, bar) do { unsigned _sp = 0; while (cond) { __builtin_amdgcn_s_sleep(1); \
    if ((++_sp & 255u) == 0u) { if (xb_ld(&(bar)[XB_TMO])) break; if (_sp > XB_SPIN_CAP) { atomicAdd(&(bar)[XB_TMO], 1u); break; } } } } while (0)
struct XcdBarrier { unsigned* bar; unsigned x; volatile LAS unsigned* st; };
__device__ __forceinline__ XcdBarrier xcd_barrier_post(unsigned* bar, volatile LAS unsigned* st) {
    XcdBarrier b; b.bar = bar; b.x = xb_xcc_id(); b.st = st;
    if (threadIdx.x == 0) (void)xb_add(&bar[XB_XCNT(b.x)], 1u);
    return b;
}
__device__ __forceinline__ void xcd_barrier_complete(unsigned* bar, unsigned x, unsigned& nloc, unsigned& nx) {
    const unsigned G = gridDim.x * gridDim.y * gridDim.z;
    unsigned sum, cnt, mine, sp = 0u;
    for (;;) {
        sum = 0u; cnt = 0u; mine = 0u;
#pragma unroll
        for (unsigned j = 0; j < 16; ++j) { const unsigned c = xb_ld(&bar[XB_XCNT(j)]); sum += c; cnt += (c > 0u) ? 1u : 0u; mine = (j == x) ? c : mine; }
        if (sum == G) break;
        __builtin_amdgcn_s_sleep(1);
        if ((++sp & 255u) == 0u) { if (xb_ld(&bar[XB_TMO])) break; if (sp > XB_SPIN_CAP) { atomicAdd(&bar[XB_TMO], 1u); break; } }
    }
    nloc = mine > 0u ? mine : 1u; nx = cnt > 0u ? cnt : 1u;
}
__device__ __forceinline__ void xcd_barrier(const XcdBarrier& b) {
    asm volatile("s_waitcnt vmcnt(0)" ::: "memory");
    __syncthreads();
    if (threadIdx.x == 0) {
        unsigned* bar = b.bar;
        __builtin_amdgcn_s_waitcnt(0);
        unsigned nloc = b.st[0], nx = b.st[1];
        if (nloc == 0u) { xcd_barrier_complete(bar, b.x, nloc, nx); b.st[0] = nloc; b.st[1] = nx; }
        const unsigned old = xb_add(&bar[XB_XSUB(b.x)], 1u);
        const unsigned gen = old / nloc;
        if (old + 1u == (gen + 1u) * nloc) {
            __builtin_amdgcn_fence(__ATOMIC_RELEASE, "agent");
            asm volatile("s_waitcnt vmcnt(0)" ::: "memory");
            const unsigned og = xb_add(&bar[XB_TOP], 1u);
            const unsigned tg = og / nx;
            if (og + 1u == (tg + 1u) * nx) xb_add(&bar[XB_TOPGEN], 1u);
            else XB_SPIN(xb_ld(&bar[XB_TOPGEN]) == tg, bar);
            __builtin_amdgcn_fence(__ATOMIC_ACQUIRE, "agent");
            xb_add(&bar[XB_XGEN(b.x)], 1u);
            asm volatile("s_waitcnt vmcnt(0)" ::: "memory");
        } else {
            XB_SPIN(xb_ld(&bar[XB_XGEN(b.x)]) == gen, bar);
            __builtin_amdgcn_fence(__ATOMIC_ACQUIRE, "agent");
            asm volatile("s_waitcnt vmcnt(0)" ::: "memory");
        }
    }
    __syncthreads();
}

__global__ void __launch_bounds__(512) fwd_kernel(Args args) {
    extern __shared__ __attribute__((aligned(16))) unsigned char shm[];
    cg::grid_group grid = cg::this_grid();
    Frame F; F.in = args.in; F.X = args.out; F.ws = args.ws; F.lds = (LAS unsigned char*)shm;
    const int wave0 = __builtin_amdgcn_readfirstlane(threadIdx.x >> 6);
    F.tid = 0; F.lane = 0; F.wave = 0;
    unsigned char* W = F.ws + WS_W; unsigned char* R = F.ws + WS_R;
    const u16* H = (const u16*)(F.ws + WS_H);
    if (threadIdx.x < 4) ((LAS unsigned*)(shm + 131072))[threadIdx.x] = 0u;
    __syncthreads();
    XcdBarrier bar = xcd_barrier_post((unsigned*)(F.ws + WS_BAR), (volatile LAS unsigned*)(shm + 131072));
    int ph = 0; bool last_phase = false;
    const int lo = args.ph_lo, hi = args.ph_hi;
#define PHASE(...) do { if (ph >= lo && ph < hi) { F.lane = lane_id_asm(); F.wave = launder_s(wave0); F.tid = F.wave * 64 + F.lane; const int bid = launder_s(blockIdx.x); (void)bid; __VA_ARGS__; if (ph + 1 < hi && !last_phase) { if (hi < 0) grid.sync(); else xcd_barrier(bar); } } ++ph; } while (0)
    PHASE({ phase_mod(F, 0, bid, gridDim.x); if (gridDim.x <= 192) phase_mod(F, 1, bid, gridDim.x); phase_convert(F, 0, 0, bid, gridDim.x); });
    PHASE(phase_init(F));
#pragma unroll 1
    for (int l = 0; l < 2; ++l) {
#pragma unroll 1
        for (int s = 0; s < 2; ++s) {
            if (s == 1) {
                PHASE({ pg8::Gemm g{H, (const u16*)(W + W_MIN), M, NMIXP, 1024}; pg8::StaticOrder S; S.init(M, NMIXP, gridDim.x, bid); EpiMixIn E{R}; REPS(4) pg8::gemm_phase(F.lds, g, S, E, F.tid); });
                PHASE({ REPS(2) phase_attn(F); REPS(6) phase_conv_a2(F, l); });
                PHASE({ pg8::Gemm g{(const u16*)(F.ws + WS_A2), (const u16*)(W + W_B2), M, N2, K2}; pg8::StaticOrder S; S.init(M, N2, gridDim.x, bid);
                        EpiLowRank E{R, (u16*)(F.ws + WS_H), F.in[I_W0] + l * 768, F.in[I_A0] + l * 768}; REPS(5) pg8::gemm_phase(F.lds, g, S, E, F.tid); });
                PHASE({ REPS(1) phase_scan(F, l); if (l == 0 && gridDim.x > 192 && bid >= 192) { phase_mod(F, 1, bid - 192, gridDim.x - 192); phase_convert(F, 1, 1, bid - 192, gridDim.x - 192); } });
                PHASE(phase_fin(F, l));
                PHASE({ pg8::Gemm g{H, (const u16*)(W + W_MOUT), M, 1024, 1024}; pg8::StaticOrder S; S.init(M, 1024, gridDim.x, bid);
                        EpiResid E{F.X, modp(F, l, 0, 1, 2), 1.0f, l * 3, F.in[I_LNG], F.in[I_LNB], F.ws, F.in[I_XP], F.in[I_XS]}; pg8::gemm_phase(F.lds, g, S, E, F.tid); });
                PHASE(phase_ln(F, l, 1, l, 2, false));
            }
            const int sub = s * 2;
            PHASE({ pg8::Gemm g{H, (const u16*)(W + W_FIN) + (size_t)s * NIN * 1024, M, NIN, 1024}; pg8::StaticOrder S; S.init(M, NIN, gridDim.x, bid);
                    EpiSwiglu E{(u16*)(R + R_HID)}; pg8::gemm_phase(F.lds, g, S, E, F.tid); });
            if (DUPK == 3) PHASE({ pg8::Gemm g{H, (const u16*)(W + W_FIN) + (size_t)s * NIN * 1024, M, NIN, 1024}; pg8::StaticOrder S; S.init(M, NIN, gridDim.x, bid);
                    EpiSwiglu E{(u16*)(R + R_HID)}; pg8::gemm_phase(F.lds, g, S, E, F.tid); });
            PHASE({ pg8::Gemm g{(const u16*)(R + R_HID), (const u16*)(W + W_FOUT) + (size_t)s * 1024 * FF, M, 1024, FF}; pg8::StaticOrder S; S.init(M, 1024, gridDim.x, bid);
                    const int pli = s == 1 ? l * 3 + 1 : l * 3 - 1;
                    EpiResid E{F.X, modp(F, l, 0, sub, 2), 0.5f, pli, F.in[I_LNG], F.in[I_LNB], F.ws, F.in[I_XP], F.in[I_XS]}; pg8::gemm_phase(F.lds, g, S, E, F.tid); });
            if (s == 0) PHASE(phase_ln(F, l, 0, l, 1, false));
            else { last_phase = (l == 1); PHASE({ phase_ln(F, l, 2, l == 0 ? 1 : -1, 0, l == 1); if (l == 0) phase_convert(F, 1, gridDim.x > 192 ? 2 : 0, bid, gridDim.x); }); }
        }
    }
#undef PHASE
}

extern "C" void kernel_launch(void* const* d_in, const int* in_sizes, int n_in, void* d_out, int out_size, void* d_ws, size_t ws_size, hipStream_t stream) {
    static int grid = 0;
    if (grid == 0) {
        if (n_in != 25 || out_size != M * D || ws_size < WS_END) { fprintf(stderr, "kernel_launch: unexpected shapes (n_in %d out %d ws %zu need %zu)\n", n_in, out_size, ws_size, (size_t)WS_END); grid = -1; return; }
        int dev = 0, cus = 0, per_cu = 0;
        hipGetDevice(&dev); hipDeviceGetAttribute(&cus, hipDeviceAttributeMultiprocessorCount, dev);
        if (hipFuncSetAttribute((const void*)fwd_kernel, hipFuncAttributeMaxDynamicSharedMemorySize, LDS_BYTES) != hipSuccess) { fprintf(stderr, "kernel_launch: hipFuncSetAttribute failed\n"); grid = -1; return; }
        if (hipOccupancyMaxActiveBlocksPerMultiprocessor(&per_cu, (const void*)fwd_kernel, 512, LDS_BYTES) != hipSuccess || per_cu < 1) { fprintf(stderr, "kernel_launch: occupancy query says %d\n", per_cu); per_cu = 1; }
        (void)hipGetLastError();
        grid = cus;
    }
    if (grid < 0) return;
    if (hipMemsetAsync((char*)d_ws + WS_BAR, 0, XCD_BAR_WORDS * 4, stream) != hipSuccess) { fprintf(stderr, "kernel_launch: memset failed\n"); return; }
    Args a{};
    for (int i = 0; i < 25; ++i) a.in[i] = (const float*)d_in[i];
    a.out = (float*)d_out; a.ws = (unsigned char*)d_ws; a.ph_lo = 0; a.ph_hi = 1000;
    void* params[] = {&a};
    hipError_t e = hipLaunchCooperativeKernel((const void*)fwd_kernel, dim3(grid), dim3(512), params, LDS_BYTES, stream);
    if (e != hipSuccess) fprintf(stderr, "cooperative launch failed: %s (grid %d)\n", hipGetErrorString(e), grid);
}
```
